# Optimizing an MI355X kernel written in HIP

```python
import jax, jax.numpy as jnp
from jax import lax
import numpy as np

D_MODEL = 1024
BATCH = 16
SEQ = 2048
DEPTH = 4

SSM_EXPAND = 2
SSM_WIDTH = SSM_EXPAND * D_MODEL
SSM_HEAD_DIM = 64
SSM_HEADS = SSM_WIDTH // SSM_HEAD_DIM
SSM_GROUPS = 2
SSM_STATE = 128
CONV_WIDTH = 4
CHUNK = 128
CONV_CH = SSM_WIDTH + 2 * SSM_GROUPS * SSM_STATE
POOL_WIDTH = D_MODEL
POOL_WINDOWS = (2, 4, 8, 16)
POOL_GROUPS = 4
POOL_GROUP_DIM = POOL_WIDTH // POOL_GROUPS
SB_WIDTH = D_MODEL
SB_HEAD_DIM = 64
SB_HEADS = SB_WIDTH // SB_HEAD_DIM
SB_BLOCK = 128
N_BRANCHES = 3
EPS = 1e-6
IN_SIZES = (SSM_WIDTH, CONV_CH, SSM_HEADS, POOL_WIDTH, POOL_WIDTH, 3 * SB_WIDTH, SB_WIDTH, N_BRANCHES * D_MODEL)
IN_COLS = SSM_WIDTH + CONV_CH + SSM_HEADS + 2 * POOL_WIDTH + 4 * SB_WIDTH + N_BRANCHES * D_MODEL

kernel_name = "hybrid_ssd_pool_stickbreak_gated_block"


def _split_points():
    pts, run = [], 0
    for s in IN_SIZES[:-1]:
        run += s
        pts.append(run)
    return pts


def rms_norm(x, w):
    xf = x.astype(jnp.float32)
    var = jnp.mean(xf * xf, axis=-1, keepdims=True)
    return (xf * lax.rsqrt(var + EPS)).astype(x.dtype) * w


def causal_dwconv(u, w, b):
    S = u.shape[1]
    up = jnp.pad(u, ((0, 0), (CONV_WIDTH - 1, 0), (0, 0)))
    out = b
    for k in range(CONV_WIDTH):
        out = out + up[:, k:k + S] * w[k]
    return out


def segsum(a):
    T = a.shape[-1]
    cs = jnp.cumsum(a, axis=-1)
    seg = cs[..., :, None] - cs[..., None, :]
    mask = jnp.tril(jnp.ones((T, T), dtype=bool))
    return jnp.where(mask, seg, -jnp.inf)


def ssd_chunked(xh, dt, a, Bg, Cg):
    Bsz, S, H, P = xh.shape
    G, N = Bg.shape[2], Bg.shape[3]
    hpg = H // G
    nc = S // CHUNK
    xdt = (xh * dt[..., None]).reshape(Bsz, nc, CHUNK, G, hpg, P)
    adt = (dt.astype(jnp.float32) * a.astype(jnp.float32)).reshape(Bsz, nc, CHUNK, G, hpg)
    adt = jnp.moveaxis(adt, 2, -1)
    Bc = Bg.reshape(Bsz, nc, CHUNK, G, N)
    Cc = Cg.reshape(Bsz, nc, CHUNK, G, N)
    a_cum = jnp.cumsum(adt, axis=-1)
    decay_in = jnp.exp(segsum(adt))
    cb = jnp.einsum('bclgn,bcsgn->bcgls', Cc, Bc)
    y_diag = jnp.einsum('bcghls,bcsghp->bclghp', cb[:, :, :, None] * decay_in, xdt)
    decay_states = jnp.exp(a_cum[..., -1:] - a_cum)
    states = jnp.einsum('bclgn,bcghl,bclghp->bcghpn', Bc, decay_states, xdt)
    chunk_decay = jnp.exp(a_cum[..., -1])

    def step(carry, inp):
        st, dec = inp
        return carry * dec[..., None, None] + st, carry

    init = jnp.zeros_like(states[:, 0])
    _, prev = lax.scan(step, init, (jnp.moveaxis(states, 1, 0), jnp.moveaxis(chunk_decay, 1, 0)))
    prev = jnp.moveaxis(prev, 0, 1)
    y_off = jnp.einsum('bclgn,bcghpn,bcghl->bclghp', Cc, prev, jnp.exp(a_cum))
    return (y_diag + y_off).reshape(Bsz, S, H, P)


def mamba2_branch(z, xbc, dt_raw, conv_w, conv_b, dt_bias, a_log, d_skip, ssm_norm_w):
    Bsz, S, _ = z.shape
    xbc = jax.nn.silu(causal_dwconv(xbc, conv_w, conv_b))
    xs, Bg, Cg = jnp.split(xbc, [SSM_WIDTH, SSM_WIDTH + SSM_GROUPS * SSM_STATE], axis=-1)
    xh = xs.reshape(Bsz, S, SSM_HEADS, SSM_HEAD_DIM)
    Bg = Bg.reshape(Bsz, S, SSM_GROUPS, SSM_STATE)
    Cg = Cg.reshape(Bsz, S, SSM_GROUPS, SSM_STATE)
    dt = jax.nn.softplus((dt_raw + dt_bias).astype(jnp.float32))
    a = -jnp.exp(a_log.astype(jnp.float32))
    y = ssd_chunked(xh, dt, a, Bg, Cg) + xh * d_skip[:, None]
    y = y.reshape(Bsz, S, SSM_WIDTH).astype(z.dtype)
    return rms_norm(y * jax.nn.silu(z), ssm_norm_w)


def pool_branch(u, gate, pool_w, pool_scale):
    Bsz, S, _ = u.shape
    uf = u.astype(jnp.float32).reshape(Bsz, S, POOL_GROUPS, POOL_GROUP_DIM)
    cs = jnp.cumsum(uf, axis=1)
    pos = jnp.arange(S)
    pooled = []
    for g, w in enumerate(POOL_WINDOWS):
        csw = jnp.pad(cs[:, :, g], ((0, 0), (w, 0), (0, 0)))
        win_sum = csw[:, w:] - csw[:, :S]
        cnt = jnp.minimum(pos + 1, w).astype(jnp.float32)
        pooled.append(win_sum / cnt[None, :, None])
    mixed = jnp.stack(pooled, axis=2) - uf
    mixed = jnp.einsum('bsgi,gio->bsgo', mixed.astype(u.dtype), pool_w).reshape(Bsz, S, POOL_WIDTH)
    return (mixed * pool_scale * jax.nn.silu(gate)).astype(u.dtype)


def stick_breaking_branch(qkv, gate):
    Bsz, S, _ = qkv.shape
    q, k, v = jnp.split(qkv, 3, axis=-1)

    def heads(t):
        return t.reshape(Bsz, S, SB_HEADS, SB_HEAD_DIM).transpose(0, 2, 1, 3)

    q, k, v = heads(q), heads(k), heads(v)
    scale = SB_HEAD_DIM ** -0.5
    outs = []
    for i in range(S // SB_BLOCK):
        q0 = i * SB_BLOCK
        kend = q0 + SB_BLOCK
        qb = q[:, :, q0:kend]
        kb = k[:, :, :kend]
        vb = v[:, :, :kend]
        z = jnp.einsum('bhtd,bhsd->bhts', qb, kb).astype(jnp.float32) * scale
        causal = (q0 + jnp.arange(SB_BLOCK))[:, None] > jnp.arange(kend)[None, :]
        log_beta = jax.nn.log_sigmoid(z)
        log_one_minus = jnp.where(causal, jax.nn.log_sigmoid(-z), 0.0)
        later = lax.cumsum(log_one_minus, axis=3, reverse=True) - log_one_minus
        att = jnp.where(causal, jnp.exp(log_beta + later), 0.0)
        outs.append(jnp.einsum('bhts,bhsd->bhtd', att.astype(vb.dtype), vb))
    o = jnp.concatenate(outs, axis=2).transpose(0, 2, 1, 3).reshape(Bsz, S, SB_WIDTH)
    return o * jax.nn.silu(gate)


def hybrid_layer(x, norm_w, w_in, conv_w, conv_b, dt_bias, a_log, d_skip, ssm_norm_w,
                 pool_w, pool_scale, w_proj_ssm, w_proj_pool, w_proj_sb, w_out):
    Bsz, S, D = x.shape
    h = rms_norm(x, norm_w)
    proj = h @ w_in
    z, xbc, dt_raw, pool_u, pool_gate, qkv, sb_gate, merge = jnp.split(proj, _split_points(), axis=-1)
    y_ssm = mamba2_branch(z, xbc, dt_raw, conv_w, conv_b, dt_bias, a_log, d_skip, ssm_norm_w) @ w_proj_ssm
    y_pool = pool_branch(pool_u, pool_gate, pool_w, pool_scale) @ w_proj_pool
    y_sb = stick_breaking_branch(qkv, sb_gate) @ w_proj_sb
    g = jax.nn.sigmoid(merge.astype(jnp.float32)).reshape(Bsz, S, N_BRANCHES, D).astype(x.dtype)
    merged = g[:, :, 0] * y_ssm + g[:, :, 1] * y_pool + g[:, :, 2] * y_sb
    return x + (merged @ w_out).astype(x.dtype)


def setup_inputs(seed: int = 0) -> dict:
    key = jax.random.key(seed)
    ks = jax.random.split(key, 17)
    f32 = jnp.float32
    nrm = lambda k, shape, s: jax.random.normal(k, shape, f32) * s
    dt = jnp.exp(jax.random.uniform(ks[5], (DEPTH, SSM_HEADS), f32, float(np.log(1e-3)), float(np.log(1e-1))))
    return {
        "x": nrm(ks[0], (BATCH, SEQ, D_MODEL), 1.0),
        "norm_w": 1.0 + nrm(ks[1], (DEPTH, D_MODEL), 0.02),
        "w_in": nrm(ks[2], (DEPTH, D_MODEL, IN_COLS), D_MODEL ** -0.5),
        "conv_w": nrm(ks[3], (DEPTH, CONV_WIDTH, CONV_CH), CONV_WIDTH ** -0.5),
        "conv_b": nrm(ks[4], (DEPTH, CONV_CH), 0.02),
        "dt_bias": dt + jnp.log(-jnp.expm1(-dt)),
        "a_log": jnp.log(jax.random.uniform(ks[6], (DEPTH, SSM_HEADS), f32, 1.0, 16.0)),
        "d_skip": 1.0 + nrm(ks[7], (DEPTH, SSM_HEADS), 0.02),
        "ssm_norm_w": 1.0 + nrm(ks[8], (DEPTH, SSM_WIDTH), 0.02),
        "pool_w": nrm(ks[9], (DEPTH, POOL_GROUPS, POOL_GROUP_DIM, POOL_GROUP_DIM), POOL_GROUP_DIM ** -0.5),
        "pool_scale": 1.0 + nrm(ks[10], (DEPTH, POOL_WIDTH), 0.02),
        "w_proj_ssm": nrm(ks[11], (DEPTH, SSM_WIDTH, D_MODEL), SSM_WIDTH ** -0.5),
        "w_proj_pool": nrm(ks[12], (DEPTH, POOL_WIDTH, D_MODEL), POOL_WIDTH ** -0.5),
        "w_proj_sb": nrm(ks[13], (DEPTH, SB_WIDTH, D_MODEL), SB_WIDTH ** -0.5),
        "w_out": nrm(ks[14], (DEPTH, D_MODEL, D_MODEL), (N_BRANCHES * D_MODEL) ** -0.5),
        "final_norm_w": 1.0 + nrm(ks[15], (D_MODEL,), 0.02),
    }


def reference(x, norm_w, w_in, conv_w, conv_b, dt_bias, a_log, d_skip, ssm_norm_w,
              pool_w, pool_scale, w_proj_ssm, w_proj_pool, w_proj_sb, w_out, final_norm_w):
    for l in range(DEPTH):
        x = hybrid_layer(x, norm_w[l], w_in[l], conv_w[l], conv_b[l], dt_bias[l], a_log[l],
                         d_skip[l], ssm_norm_w[l], pool_w[l], pool_scale[l], w_proj_ssm[l],
                         w_proj_pool[l], w_proj_sb[l], w_out[l])
    return rms_norm(x, final_norm_w)
```

```cpp
#include <hip/hip_runtime.h>
#include <hip/hip_cooperative_groups.h>
#include <cstdio>
#include <cstdint>
namespace cg = cooperative_groups;

#ifndef P1_WGM
#define P1_WGM 4
#endif
#ifndef N_LAUNCH_MODE
#define N_LAUNCH_MODE 1
#endif

#define LAS __attribute__((address_space(3)))
typedef unsigned short bf16_t;
typedef short bf16x8 __attribute__((ext_vector_type(8)));
typedef float f32x4 __attribute__((ext_vector_type(4)));
typedef unsigned u32x4 __attribute__((ext_vector_type(4)));
typedef unsigned u32x2 __attribute__((ext_vector_type(2)));

constexpr int DM = 1024, BATCH = 16, SEQ = 2048, DEPTH = 4;
constexpr int M_ALL = BATCH * SEQ;
constexpr int MH = M_ALL / 2;
constexpr int SSM_W = 2048, NHEAD = 32, CONV_CH = 2560, IN_COLS = 13856, NPAD = 14080;
constexpr float EPS = 1e-6f;

constexpr size_t al256(size_t x) { return (x + 255) & ~(size_t)255; }
constexpr size_t WS_WIN   = 0;
constexpr size_t WS_WSSM  = WS_WIN   + (size_t)DEPTH * NPAD * 1024 * 2;
constexpr size_t WS_WPOOL = WS_WSSM  + (size_t)DEPTH * 1024 * 2048 * 2;
constexpr size_t WS_WSB   = WS_WPOOL + (size_t)DEPTH * 1024 * 1024 * 2;
constexpr size_t WS_WOUT  = WS_WSB   + (size_t)DEPTH * 1024 * 1024 * 2;
constexpr size_t WS_PW    = WS_WOUT  + (size_t)DEPTH * 1024 * 1024 * 2;
constexpr size_t WS_XB    = WS_PW    + (size_t)DEPTH * 1024 * 256 * 2;
constexpr size_t WS_XSS   = WS_XB    + (size_t)M_ALL * 1024 * 2;
constexpr size_t WS_ZS    = WS_XSS   + (size_t)M_ALL * 16 * 4;
constexpr size_t WS_XBC   = WS_ZS    + (size_t)MH * 2048 * 2;
constexpr size_t WS_DT    = WS_XBC   + (size_t)MH * 2560 * 2;
constexpr size_t WS_PU    = WS_DT    + (size_t)MH * 32 * 4;
constexpr size_t WS_PG    = WS_PU    + (size_t)MH * 1024 * 2;
constexpr size_t WS_QKV   = WS_PG    + (size_t)MH * 1024 * 2;
constexpr size_t WS_SG    = WS_QKV   + (size_t)MH * 3072 * 2;
constexpr size_t WS_MG    = WS_SG    + (size_t)MH * 1024 * 2;
constexpr size_t WS_XBCC  = WS_MG    + (size_t)MH * 3072 * 2;
constexpr size_t WS_MACC  = WS_XBCC;
constexpr size_t WS_MIXED = WS_XBCC  + (size_t)MH * 2560 * 2;
constexpr size_t WS_MB    = WS_MIXED;
constexpr size_t WS_SBO   = WS_MIXED + (size_t)MH * 1024 * 2;
constexpr size_t WS_SSQ   = WS_SBO   + (size_t)MH * 1024 * 2;
constexpr size_t WS_BAR   = WS_SSQ   + (size_t)MH * 32 * 4;
constexpr size_t WS_BAR_BYTES = 16384;
constexpr size_t WS_END   = WS_BAR   + WS_BAR_BYTES;

constexpr int LDS_BYTES = 147456;
constexpr int RS_OFF = 131072;

typedef float f32x2 __attribute__((ext_vector_type(2)));
typedef __bf16 bf2_t __attribute__((ext_vector_type(2)));
typedef float f32x16 __attribute__((ext_vector_type(16)));
__device__ __forceinline__ unsigned pk2(float lo, float hi) { const bf2_t v = __builtin_convertvector((f32x2){lo, hi}, bf2_t); return __builtin_bit_cast(unsigned, v); }
#define MFMA32(a, b, c) __builtin_amdgcn_mfma_f32_32x32x16_bf16((a), (b), (c), 0, 0, 0)
__device__ __forceinline__ float bflo(unsigned u) { return __uint_as_float(u << 16); }
__device__ __forceinline__ float bfhi(unsigned u) { return __uint_as_float(u & 0xffff0000u); }
__device__ __forceinline__ void unpack8(const u32x4 w, float (&f)[8]) {
    f[0] = bflo(w.x); f[1] = bfhi(w.x); f[2] = bflo(w.y); f[3] = bfhi(w.y); f[4] = bflo(w.z); f[5] = bfhi(w.z); f[6] = bflo(w.w); f[7] = bfhi(w.w);
}
__device__ __forceinline__ u32x4 pack8(const float (&f)[8]) { u32x4 w; w.x = pk2(f[0], f[1]); w.y = pk2(f[2], f[3]); w.z = pk2(f[4], f[5]); w.w = pk2(f[6], f[7]); return w; }
__device__ __forceinline__ float sigmoidf_(float v) { return __builtin_amdgcn_rcpf(1.f + __expf(-v)); }
__device__ __forceinline__ float siluf_(float v) { return v * sigmoidf_(v); }
__device__ __forceinline__ float shx(float v, int mask, int lane) { return __int_as_float(__builtin_amdgcn_ds_bpermute((lane ^ mask) << 2, __float_as_int(v))); }
__device__ __forceinline__ float wave_sum(float v, int lane) {
#pragma unroll
    for (int o = 1; o < 64; o <<= 1) v += shx(v, o, lane);
    return v;
}

__device__ __forceinline__ int tid_opaque(int wv) { int t = wv * 64 + (int)__builtin_amdgcn_mbcnt_hi(~0u, __builtin_amdgcn_mbcnt_lo(~0u, 0u)); asm volatile("" : "+v"(t)); return t; }

#define XB_TMO      128
#define XB_XCNT(j)  (256  + 64 * (j))
#define XB_XSUB(j)  (1280 + 64 * (j))
#define XB_XGEN(j)  (2304 + 64 * (j))
#define XB_TOP      3328
#define XB_TOPGEN   3392
#define XCD_BAR_WORDS 3456
#define XB_SPIN_CAP (1u << 18)

__device__ __forceinline__ unsigned xb_ld(unsigned* p)              { return __hip_atomic_load(p, __ATOMIC_RELAXED, __HIP_MEMORY_SCOPE_AGENT); }
__device__ __forceinline__ unsigned xb_add(unsigned* p, unsigned v) { return __hip_atomic_fetch_add(p, v, __ATOMIC_RELAXED, __HIP_MEMORY_SCOPE_AGENT); }
__device__ __forceinline__ unsigned xb_xcc_id() { return (unsigned)__builtin_amdgcn_s_getreg((3 << 11) | 20) & 0xFu; }
#define XB_SPIN(cond, bar) do { unsigned _sp = 0; while (cond) { __builtin_amdgcn_s_sleep(1); \
    if ((++_sp & 255u) == 0u) { if (xb_ld(&(bar)[XB_TMO])) break; if (_sp > XB_SPIN_CAP) { atomicAdd(&(bar)[XB_TMO], 1u); break; } } } } while (0)

struct XcdBarrier {
    unsigned* bar; unsigned x;
    volatile LAS unsigned* st;
};

__device__ __forceinline__ XcdBarrier xcd_barrier_post(unsigned* bar, volatile LAS unsigned* st, bool is_t0) {
    XcdBarrier b; b.bar = bar; b.x = xb_xcc_id(); b.st = st;
    if (is_t0) (void)xb_add(&bar[XB_XCNT(b.x)], 1u);
    return b;
}
__device__ __forceinline__ void xcd_barrier_complete(unsigned* bar, unsigned x, unsigned& nloc, unsigned& nx) {
    const unsigned G = gridDim.x * gridDim.y * gridDim.z;
    unsigned sum, cnt, mine, sp = 0u;
    for (;;) {
        sum = 0u; cnt = 0u; mine = 0u;
#pragma unroll
        for (unsigned j = 0; j < 16; ++j) { const unsigned c = xb_ld(&bar[XB_XCNT(j)]); sum += c; cnt += (c > 0u) ? 1u : 0u; mine = (j == x) ? c : mine; }
        if (sum == G) break;
        __builtin_amdgcn_s_sleep(1);
        if ((++sp & 255u) == 0u) { if (xb_ld(&bar[XB_TMO])) break; if (sp > XB_SPIN_CAP) { atomicAdd(&bar[XB_TMO], 1u); break; } }
    }
    nloc = mine > 0u ? mine : 1u; nx = cnt > 0u ? cnt : 1u;
}

__device__ __forceinline__ void xcd_barrier(const XcdBarrier& b, bool is_t0) {
    asm volatile("s_waitcnt vmcnt(0)" ::: "memory");
    __syncthreads();
    if (is_t0) {
        unsigned* bar = b.bar;
        __builtin_amdgcn_s_waitcnt(0);
        unsigned nloc = b.st[0], nx = b.st[1];
        if (nloc == 0u) { xcd_barrier_complete(bar, b.x, nloc, nx); b.st[0] = nloc; b.st[1] = nx; }
        const unsigned old = xb_add(&bar[XB_XSUB(b.x)], 1u);
        const unsigned gen = old / nloc;
        if (old + 1u == (gen + 1u) * nloc) {
            __builtin_amdgcn_fence(__ATOMIC_RELEASE, "agent");
            asm volatile("s_waitcnt vmcnt(0)" ::: "memory");
            const unsigned og = xb_add(&bar[XB_TOP], 1u);
            const unsigned tg = og / nx;
            if (og + 1u == (tg + 1u) * nx) xb_add(&bar[XB_TOPGEN], 1u);
            else XB_SPIN(xb_ld(&bar[XB_TOPGEN]) == tg, bar);
            __builtin_amdgcn_fence(__ATOMIC_ACQUIRE, "agent");
            xb_add(&bar[XB_XGEN(b.x)], 1u);
            asm volatile("s_waitcnt vmcnt(0)" ::: "memory");
        } else {
            XB_SPIN(xb_ld(&bar[XB_XGEN(b.x)]) == gen, bar);
            __builtin_amdgcn_fence(__ATOMIC_ACQUIRE, "agent");
            asm volatile("s_waitcnt vmcnt(0)" ::: "memory");
        }
    }
    __syncthreads();
}

namespace pg8 {
constexpr int BM = 256, BK = 64, HALF = 128, HTB = HALF * BK * 2, STAGE_BYTES = 8 * HTB, NXCD = 8, WGM = 8;
__host__ __device__ __forceinline__ int lds_byte(int r, int c) { const int st = (r >> 4) * 2 + (c >> 5), rr = r & 15, cc = c & 31, ob = rr * 64 + cc * 2; return st * 1024 + (ob ^ (((ob >> 9) & 1) << 5)); }
__host__ __device__ __forceinline__ void stage_rc(int b, int& R, int& C) { const int st = b / 1024, sb = b % 1024, swz = sb ^ (((sb >> 9) & 1) << 5); R = (st >> 1) * 16 + swz / 64; C = (st & 1) * 32 + (swz % 64) / 2; }
__host__ __device__ __forceinline__ int perm32(int rho) { const int n = rho >> 4, i = rho & 15; return 8 * (i >> 2) + 4 * n + (i & 3); }

struct Unit { int pm, pn, idx; };
struct Gemm { const bf16_t* A; const bf16_t* Bt; };

struct StaticOrder {
    int nM, nN, nwg, G, c, wgm;
    __device__ void init(int M, int N, int G_, int c_, int wgm_ = WGM) { nM = M / BM; nN = N / BM; nwg = nM * nN; G = G_; c = c_; wgm = wgm_; }
    __device__ bool next(int i, Unit& u) const {
        const long L = (long)i * G + c; if (L >= nwg) return false;
        int wgid = (int)L; { const int q = nwg / NXCD, r = nwg % NXCD, xcd = wgid % NXCD, off = wgid / NXCD; wgid = (xcd < r ? xcd * (q + 1) : r * (q + 1) + (xcd - r) * q) + off; }
        const int nig = wgm * nN, gid = wgid / nig, fm = gid * wgm, gsz = (nM - fm) < wgm ? (nM - fm) : wgm;
        u.pm = fm + ((wgid % nig) % gsz); u.pn = (wgid % nig) / gsz; u.idx = i; return true;
    }
};

template <class Epi, int LDA, int LDB, int KK, int APN>
__device__ __forceinline__ void gemm_phase(LAS unsigned char* lds, const Gemm g, const StaticOrder& S, const Epi& E, int wv) {
    const int tid = tid_opaque(wv), wid = __builtin_amdgcn_readfirstlane(tid >> 6), lane = tid & 63, wr = wid >> 2, wc = wid & 3, fr = lane & 15, fq = lane >> 4;
    constexpr int nt = KK / BK;
    unsigned voffA[2], voffB[2];
#pragma unroll
    for (int i = 0; i < 2; ++i) { int R, C; stage_rc(tid * 16 + i * 8192, R, C); const int Rb = (R & ~31) + perm32(R & 31);
        voffA[i] = (unsigned)(R * LDA + C) * 2u; voffB[i] = (unsigned)(Rb * LDB + C) * 2u; }
    constexpr size_t kstep = (size_t)(BK * 2);
    constexpr size_t hstepA = (size_t)HALF * LDA * 2, hstepB = (size_t)HALF * LDB * 2;
    const unsigned ldsw = (unsigned)wid * 1024u;
    const int aoff = lds_byte(wr * 64 + fr, fq * 8), boff = lds_byte(wc * 32 + fr, fq * 8);
#define PG8_SA(b, h) (((b) * 2 + (h)) * HTB)
#define PG8_SB(b, h) ((4 + (b) * 2 + (h)) * HTB)
#define PG8_STAGE(bufoff, gbase, voff) do { _Pragma("unroll") for (int _i = 0; _i < 2; ++_i) \
        __builtin_amdgcn_global_load_lds((const unsigned*)((const char*)(gbase) + (voff)[_i]), (LAS unsigned*)(lds + (bufoff) + ldsw + _i * 8192), 16, 0, 0); } while (0)
#define PG8_LDA(dst, b, h) do { _Pragma("unroll") for (int m = 0; m < 4; ++m) _Pragma("unroll") for (int k = 0; k < 2; ++k) dst[m][k] = *(const LAS bf16x8*)(lds + PG8_SA(b, h) + aoff + m * 2048 + k * 1024); } while (0)
#define PG8_LDB(dst, b, h) do { _Pragma("unroll") for (int n = 0; n < 2; ++n) _Pragma("unroll") for (int k = 0; k < 2; ++k) dst[n][k] = *(const LAS bf16x8*)(lds + PG8_SB(b, h) + boff + n * 2048 + k * 1024); } while (0)
#define PG8_MMA(ai, bj, At, Bt) do { __builtin_amdgcn_s_setprio(1); _Pragma("unroll") for (int m = 0; m < 4; ++m) _Pragma("unroll") for (int n = 0; n < 2; ++n) _Pragma("unroll") for (int k = 0; k < 2; ++k) \
        acc[ai][bj][m][n] = __builtin_amdgcn_mfma_f32_16x16x32_bf16(Bt[n][k], At[m][k], acc[ai][bj][m][n], 0, 0, 0); __builtin_amdgcn_s_setprio(0); } while (0)
#define PG8_WAIT_V(n) asm volatile("s_waitcnt vmcnt(" #n ")" ::: "memory")
#define PG8_WAIT_L(n) asm volatile("s_waitcnt lgkmcnt(" #n ")" ::: "memory")
#define PG8_BAR __builtin_amdgcn_s_barrier()
#define PG8_SCHED __builtin_amdgcn_sched_barrier(0)
#define PG8_ABASE(u) ((const char*)g.A + ((size_t)(u).pm * BM * LDA + (size_t)(u).pn * APN) * 2)
#define PG8_BBASE(u) ((const char*)g.Bt + (size_t)(u).pn * BM * LDB * 2)
    Unit cur, nxt; int ui = 0;
    if (!S.next(0, cur)) return;
    float zf = 0.f; asm volatile("" : "+v"(zf));
    f32x4 acc[2][2][4][2];
#pragma unroll
    for (int a = 0; a < 2; ++a)
#pragma unroll
        for (int b = 0; b < 2; ++b)
#pragma unroll
            for (int m = 0; m < 4; ++m)
#pragma unroll
                for (int n = 0; n < 2; ++n) acc[a][b][m][n] = (f32x4){zf, zf, zf, zf};
    bf16x8 At[4][2], B0[2][2], B1[2][2];
    const char* cA = PG8_ABASE(cur); const char* cB = PG8_BBASE(cur);
    PG8_STAGE(PG8_SB(0, 0), cB, voffB); PG8_STAGE(PG8_SB(0, 1), cB + hstepB, voffB); PG8_STAGE(PG8_SA(0, 0), cA, voffA); PG8_STAGE(PG8_SA(0, 1), cA + hstepA, voffA);
    if (wr == 1) PG8_BAR;
    PG8_WAIT_V(2); PG8_BAR;
    PG8_STAGE(PG8_SB(1, 0), cB + kstep, voffB); PG8_STAGE(PG8_SA(1, 0), cA + kstep, voffA); PG8_STAGE(PG8_SB(1, 1), cB + hstepB + kstep, voffB);
    PG8_WAIT_V(6); PG8_BAR;
    for (;;) {
        const bool has_next = S.next(ui + 1, nxt);
        const char* nA = has_next ? PG8_ABASE(nxt) : cA; const char* nB = has_next ? PG8_BBASE(nxt) : cB;
#pragma nounroll
        for (int t = 0; t < nt; t += 2) {
            const bool last = (t == nt - 2);
            const char* a1 = cA + (size_t)(t + 1) * kstep;
            const char* a2 = last ? nA : cA + (size_t)(t + 2) * kstep; const char* b2 = last ? nB : cB + (size_t)(t + 2) * kstep;
            const char* a3 = a2 + kstep; const char* b3 = b2 + kstep;
            PG8_LDB(B0, 0, 0); PG8_LDB(B1, 0, 1); PG8_SCHED; PG8_LDA(At, 0, 0); PG8_STAGE(PG8_SA(1, 1), a1 + hstepA, voffA);
            PG8_WAIT_V(8); PG8_WAIT_L(0); PG8_BAR; PG8_MMA(0, 0, At, B0); PG8_MMA(0, 1, At, B1); PG8_BAR; PG8_SCHED;
            PG8_LDA(At, 0, 1); PG8_STAGE(PG8_SB(0, 0), b2, voffB); PG8_STAGE(PG8_SB(0, 1), b2 + hstepB, voffB); PG8_STAGE(PG8_SA(0, 0), a2, voffA);
            PG8_WAIT_V(8); PG8_WAIT_L(0); PG8_BAR; PG8_MMA(1, 0, At, B0); PG8_MMA(1, 1, At, B1); PG8_BAR; PG8_SCHED;
            PG8_LDB(B0, 1, 0); PG8_LDB(B1, 1, 1); PG8_SCHED; PG8_LDA(At, 1, 0); PG8_STAGE(PG8_SA(0, 1), a2 + hstepA, voffA);
            PG8_WAIT_V(8); PG8_WAIT_L(0); PG8_BAR; PG8_MMA(0, 0, At, B0); PG8_MMA(0, 1, At, B1); PG8_BAR; PG8_SCHED;
            PG8_LDA(At, 1, 1); PG8_STAGE(PG8_SB(1, 0), b3, voffB); PG8_STAGE(PG8_SB(1, 1), b3 + hstepB, voffB); PG8_STAGE(PG8_SA(1, 0), a3, voffA);
            PG8_WAIT_V(8); PG8_WAIT_L(0); PG8_BAR; PG8_MMA(1, 0, At, B0); PG8_MMA(1, 1, At, B1); PG8_BAR; PG8_SCHED;
        }
        if (wr == 0) PG8_BAR;
        E(acc, cur, wr, wc, fr, fq);
        if (!has_next) break;
#pragma unroll
        for (int a = 0; a < 2; ++a)
#pragma unroll
            for (int b = 0; b < 2; ++b)
#pragma unroll
                for (int m = 0; m < 4; ++m)
#pragma unroll
                    for (int n = 0; n < 2; ++n) acc[a][b][m][n] = (f32x4){zf, zf, zf, zf};
        cur = nxt; cA = nA; cB = nB; ++ui;
        if (wr == 1) PG8_BAR;
    }
    PG8_WAIT_V(0);
    PG8_BAR;
#undef PG8_SA
#undef PG8_SB
#undef PG8_STAGE
#undef PG8_LDA
#undef PG8_LDB
#undef PG8_MMA
#undef PG8_WAIT_V
#undef PG8_WAIT_L
#undef PG8_BAR
#undef PG8_SCHED
#undef PG8_ABASE
#undef PG8_BBASE
}
}
using pg8::Unit;

typedef const f32x4 (&AccRef)[2][2][4][2];

struct EpiInProj {
    const LAS float* rsl;
    unsigned char* ws; const float* dt_bias;
    __device__ __forceinline__ void operator()(AccRef acc, const Unit& u, int wr, int wc, int fr, int fq) const {
        run(acc, u, wr, wc, fr, fq);
    }
    __device__ __forceinline__ void run(AccRef acc, const Unit& u, int wr, int wc, int fr, int fq) const {
        const int pn = u.pn, row0 = u.pm * 256 + wr * 64 + fr;
        bf16_t* const zs = (bf16_t*)(ws + WS_ZS); bf16_t* const xbc = (bf16_t*)(ws + WS_XBC); bf16_t* const pu = (bf16_t*)(ws + WS_PU); bf16_t* const pg = (bf16_t*)(ws + WS_PG);
        bf16_t* const qkv = (bf16_t*)(ws + WS_QKV); bf16_t* const sg = (bf16_t*)(ws + WS_SG); bf16_t* const mg = (bf16_t*)(ws + WS_MG); float* const dt = (float*)(ws + WS_DT);
        float rs[2][4];
#pragma unroll
        for (int ai = 0; ai < 2; ++ai)
#pragma unroll
            for (int m = 0; m < 4; ++m) rs[ai][m] = rsl[u.idx * 256 + ai * 128 + wr * 64 + m * 16 + fr];
        if (pn == 18) {
            if (wc == 0) {
                const f32x4 bvn[2] = {*(const f32x4*)(dt_bias + 8 * fq), *(const f32x4*)(dt_bias + 8 * fq + 4)};
#pragma unroll
                for (int ai = 0; ai < 2; ++ai)
#pragma unroll
                    for (int m = 0; m < 4; ++m) { const int row = row0 + ai * 128 + m * 16;
#pragma unroll
                        for (int n = 0; n < 2; ++n) { const f32x4 bv = bvn[n]; f32x4 v = acc[ai][0][m][n] * rs[ai][m] + bv; f32x4 o;
#pragma unroll
                            for (int j = 0; j < 4; ++j) o[j] = fmaxf(v[j], 0.f) + log1pf(__expf(-fabsf(v[j])));
                            *(f32x4*)(dt + (size_t)row * 32 + 8 * fq + 4 * n) = o; } }
            }
            return;
        }
        bf16_t* base; int ld, ct, type; float sc = 1.f;
        if (pn < 8)       { base = zs;  ld = 2048; ct = pn;      type = 0; }
        else if (pn < 18) { base = xbc; ld = 2560; ct = pn - 8;  type = 0; }
        else if (pn < 23) { base = pu;  ld = 1024; ct = pn - 19; type = 0; }
        else if (pn < 27) { base = pg;  ld = 1024; ct = pn - 23; type = 1; }
        else if (pn < 39) { base = qkv; ld = 3072; ct = pn - 27; type = 0; sc = (pn < 31) ? 0.125f * 1.4426950408889634f : 1.f; }
        else if (pn < 43) { base = sg;  ld = 1024; ct = pn - 39; type = 0; }
        else              { base = mg;  ld = 3072; ct = pn - 43; type = 2; }
#pragma unroll
        for (int ai = 0; ai < 2; ++ai)
#pragma unroll
            for (int m = 0; m < 4; ++m) { bf16_t* rowp = base + (size_t)(row0 + ai * 128 + m * 16) * ld + ct * 256 + wc * 32 + 8 * fq; const float r = rs[ai][m] * sc;
#pragma unroll
                for (int bj = 0; bj < 2; ++bj) { f32x4 v0 = acc[ai][bj][m][0] * r, v1 = acc[ai][bj][m][1] * r;
                    if (type == 1) {
#pragma unroll
                        for (int j = 0; j < 4; ++j) { v0[j] = siluf_(v0[j]); v1[j] = siluf_(v1[j]); } }
                    else if (type == 2) {
#pragma unroll
                        for (int j = 0; j < 4; ++j) { v0[j] = sigmoidf_(v0[j]); v1[j] = sigmoidf_(v1[j]); } }
                    u32x4 w; w.x = pk2(v0[0], v0[1]); w.y = pk2(v0[2], v0[3]); w.z = pk2(v1[0], v1[1]); w.w = pk2(v1[2], v1[3]);
                    *(u32x4*)(rowp + bj * 128) = w; } }
    }
};

__device__ __forceinline__ void p1_rstd(const float* xss, const pg8::StaticOrder& S, LAS float* rsl, int wv) {
    const int tid = tid_opaque(wv), row = tid >> 1, hf2 = tid & 1, lane = tid & 63;
#pragma unroll 1
    for (int i0 = 0; i0 < 16; i0 += 8) {
        f32x4 v[8][2]; bool ok[8];
#pragma unroll
        for (int j = 0; j < 8; ++j) { Unit u; ok[j] = S.next(i0 + j, u); const int pm = ok[j] ? u.pm : 0; const f32x4* p = (const f32x4*)(xss + (size_t)(pm * 256 + row) * 16 + hf2 * 8); v[j][0] = p[0]; v[j][1] = p[1]; }
#pragma unroll
        for (int j = 0; j < 8; ++j) { float sm = ((v[j][0].x + v[j][0].y) + (v[j][0].z + v[j][0].w)) + ((v[j][1].x + v[j][1].y) + (v[j][1].z + v[j][1].w)); sm += shx(sm, 1, lane);
            if (ok[j] && hf2 == 0 && i0 + j < 15) rsl[(i0 + j) * 256 + row] = __builtin_amdgcn_rsqf(sm * (1.f / DM) + EPS); }
    }
    __syncthreads();
}


struct EpiPool {
    unsigned char* ws; const float* pscale;
    __device__ __forceinline__ int nstores(const Unit&) const { return 0; }
    __device__ __forceinline__ void operator()(AccRef acc, const Unit& u, int wr, int wc, int fr, int fq) const {
        bf16_t* const out = (bf16_t*)(ws + WS_PU); const bf16_t* const pg = (const bf16_t*)(ws + WS_PG);
        const int row0 = u.pm * 256 + wr * 64 + fr, col0 = u.pn * 256 + wc * 32 + 8 * fq;
        u32x4 gw[2][2][4]; f32x4 s0[2], s1[2];
#pragma unroll
        for (int bj = 0; bj < 2; ++bj) { s0[bj] = *(const f32x4*)(pscale + col0 + bj * 128); s1[bj] = *(const f32x4*)(pscale + col0 + bj * 128 + 4);
#pragma unroll
            for (int ai = 0; ai < 2; ++ai)
#pragma unroll
                for (int m = 0; m < 4; ++m) gw[bj][ai][m] = *(const u32x4*)(pg + (size_t)(row0 + ai * 128 + m * 16) * 1024 + col0 + bj * 128); }
        __builtin_amdgcn_sched_barrier(0);
#pragma unroll
        for (int bj = 0; bj < 2; ++bj)
#pragma unroll
            for (int ai = 0; ai < 2; ++ai)
#pragma unroll
                for (int m = 0; m < 4; ++m) { const size_t off = (size_t)(row0 + ai * 128 + m * 16) * 1024 + col0 + bj * 128; float gf[8]; unpack8(gw[bj][ai][m], gf);
                    const f32x4 v0 = acc[ai][bj][m][0] * s0[bj], v1 = acc[ai][bj][m][1] * s1[bj];
                    u32x4 w; w.x = pk2(v0[0] * gf[0], v0[1] * gf[1]); w.y = pk2(v0[2] * gf[2], v0[3] * gf[3]); w.z = pk2(v1[0] * gf[4], v1[1] * gf[5]); w.w = pk2(v1[2] * gf[6], v1[3] * gf[7]);
                    *(u32x4*)(out + off) = w; }
    }
};

template <int STEP> struct EpiMerge {
    unsigned char* ws; const LAS float* rsl;
    __device__ __forceinline__ int nstores(const Unit&) const { return 0; }
    __device__ __forceinline__ void operator()(AccRef acc, const Unit& u, int wr, int wc, int fr, int fq) const {
        const bf16_t* const mg = (const bf16_t*)(ws + WS_MG); bf16_t* const mb = (bf16_t*)(ws + WS_MB);
        const int row0 = u.pm * 256 + wr * 64 + fr, col0 = u.pn * 256 + wc * 32 + 8 * fq;
#pragma unroll
        for (int ai = 0; ai < 2; ++ai) {
            u32x4 gw[4][2], mw[4][2]; float r[4];
#pragma unroll
            for (int m = 0; m < 4; ++m) { const int row = row0 + ai * 128 + m * 16; r[m] = (STEP == 0) ? rsl[u.idx * 256 + ai * 128 + wr * 64 + m * 16 + fr] : 1.f;
#pragma unroll
                for (int bj = 0; bj < 2; ++bj) { gw[m][bj] = *(const u32x4*)(mg + (size_t)row * 3072 + STEP * 1024 + col0 + bj * 128);
                    if (STEP != 0) mw[m][bj] = *(const u32x4*)(mb + (size_t)row * 1024 + col0 + bj * 128); } }
            __builtin_amdgcn_sched_barrier(0);
#pragma unroll
            for (int m = 0; m < 4; ++m)
#pragma unroll
                for (int bj = 0; bj < 2; ++bj) { float gf[8]; unpack8(gw[m][bj], gf);
                    f32x4 v0 = acc[ai][bj][m][0] * r[m], v1 = acc[ai][bj][m][1] * r[m];
                    v0[0] *= gf[0]; v0[1] *= gf[1]; v0[2] *= gf[2]; v0[3] *= gf[3]; v1[0] *= gf[4]; v1[1] *= gf[5]; v1[2] *= gf[6]; v1[3] *= gf[7];
                    if (STEP != 0) { float pf[8]; unpack8(mw[m][bj], pf); v0[0] += pf[0]; v0[1] += pf[1]; v0[2] += pf[2]; v0[3] += pf[3]; v1[0] += pf[4]; v1[1] += pf[5]; v1[2] += pf[6]; v1[3] += pf[7]; }
                    u32x4 w; w.x = pk2(v0[0], v0[1]); w.y = pk2(v0[2], v0[3]); w.z = pk2(v1[0], v1[1]); w.w = pk2(v1[2], v1[3]);
                    *(u32x4*)(mb + (size_t)(row0 + ai * 128 + m * 16) * 1024 + col0 + bj * 128) = w; }
            __builtin_amdgcn_sched_barrier(0);
        }
    }
};
__device__ __forceinline__ void p3_rstd(const float* ssq, const pg8::StaticOrder& S, LAS float* rsl, int wv) {
    const int tid = tid_opaque(wv), row = tid >> 1, hf2 = tid & 1, lane = tid & 63;
#pragma unroll 1
    for (int i = 0; i < 15; ++i) { Unit u; if (!S.next(i, u)) break;
        const f32x4* p = (const f32x4*)(ssq + (size_t)(u.pm * 256 + row) * 32 + hf2 * 16); const f32x4 a = p[0], b = p[1], c = p[2], d = p[3];
        float sm = (((a.x + a.y) + (a.z + a.w)) + ((b.x + b.y) + (b.z + b.w))) + (((c.x + c.y) + (c.z + c.w)) + ((d.x + d.y) + (d.z + d.w))); sm += shx(sm, 1, lane);
        if (hf2 == 0) rsl[i * 256 + row] = __builtin_amdgcn_rsqf(sm * (1.f / SSM_W) + EPS); }
    __syncthreads();
}

template <bool DRY> struct EpiOutT {
    const float* xin; float* x; bf16_t* xb; float* xss;
    __device__ __forceinline__ int nstores(const Unit&) const { return 0; }
    __device__ __forceinline__ void operator()(AccRef acc, const Unit& u, int wr, int wc, int fr, int fq) const {
        const int row0 = u.pm * 256 + wr * 64 + fr, col0 = u.pn * 256 + wc * 32 + 8 * fq;
#pragma unroll
        for (int ai = 0; ai < 2; ++ai) {
            f32x4 xv[4][2][2];
#pragma unroll
            for (int m = 0; m < 4; ++m)
#pragma unroll
                for (int bj = 0; bj < 2; ++bj) { const size_t off = (size_t)(row0 + ai * 128 + m * 16) * 1024 + col0 + bj * 128; xv[m][bj][0] = *(const f32x4*)(xin + off); xv[m][bj][1] = *(const f32x4*)(xin + off + 4); }
            __builtin_amdgcn_sched_barrier(0);
#pragma unroll
            for (int m = 0; m < 4; ++m) { const int row = row0 + ai * 128 + m * 16; float ss = 0.f;
#pragma unroll
                for (int bj = 0; bj < 2; ++bj) { const size_t off = (size_t)row * 1024 + col0 + bj * 128;
                    const f32x4 v0 = acc[ai][bj][m][0] + xv[m][bj][0], v1 = acc[ai][bj][m][1] + xv[m][bj][1];
                    if (!DRY) { *(f32x4*)(x + off) = v0; *(f32x4*)(x + off + 4) = v1; }
                    ss += (v0[0] * v0[0] + v0[1] * v0[1]) + (v0[2] * v0[2] + v0[3] * v0[3]) + (v1[0] * v1[0] + v1[1] * v1[1]) + (v1[2] * v1[2] + v1[3] * v1[3]);
                    u32x4 w; w.x = pk2(v0[0], v0[1]); w.y = pk2(v0[2], v0[3]); w.z = pk2(v1[0], v1[1]); w.w = pk2(v1[2], v1[3]); if (!DRY && xb) *(u32x4*)(xb + off) = w; }
                { const int ln = fr + 16 * fq; ss += shx(ss, 16, ln); ss += shx(ss, 32, ln); }
                if (!DRY && fq == 0) xss[(size_t)row * 16 + u.pn * 4 + wc] = ss; }
            __builtin_amdgcn_sched_barrier(0);
        }
    }
};

struct EpiMulti {
    int mode; EpiInProj ip; EpiMerge<1> m1; EpiMerge<2> m2; EpiOutT<false> eo;
    __device__ __forceinline__ void operator()(AccRef acc, const Unit& u, int wr, int wc, int fr, int fq) const {
        if (mode == 0) ip(acc, u, wr, wc, fr, fq); else if (mode == 1) m1(acc, u, wr, wc, fr, fq); else if (mode == 2) m2(acc, u, wr, wc, fr, fq); else eo(acc, u, wr, wc, fr, fq);
    }
};

struct Args {
    const float *x, *norm_w, *w_in, *conv_w, *conv_b, *dt_bias, *a_log, *d_skip, *ssm_norm_w, *pool_w, *pool_scale, *w_proj_ssm, *w_proj_pool, *w_proj_sb, *w_out, *final_norm_w;
    float* out; unsigned char* ws; int ph_lo, ph_hi;
};

__device__ __forceinline__ void transpose_item(const float* W, int K, int N, bf16_t* WT, int dst_row0, const float* kscale, LAS float* scr, int kb, int nb, int lane) {
    const int k0 = 64 * kb, n0 = 32 * nb;
    f32x4 wv_[8];
#pragma unroll
    for (int j = 0; j < 8; ++j) wv_[j] = *(const f32x4*)(W + (size_t)(k0 + 8 * j + (lane >> 3)) * N + n0 + 4 * (lane & 7));
    const int c = lane & 7;
    f32x4 ks0 = (f32x4){1.f, 1.f, 1.f, 1.f}, ks1 = ks0;
    if (kscale) { ks0 = *(const f32x4*)(kscale + k0 + 8 * c); ks1 = *(const f32x4*)(kscale + k0 + 8 * c + 4); }
#pragma unroll
    for (int j = 0; j < 8; ++j) { LAS float* d = scr + (8 * j + (lane >> 3)) * 33 + 4 * (lane & 7); d[0] = wv_[j].x; d[1] = wv_[j].y; d[2] = wv_[j].z; d[3] = wv_[j].w; }
    asm volatile("s_waitcnt lgkmcnt(0)" ::: "memory");
#pragma unroll
    for (int j = 0; j < 4; ++j) { const int n = (lane >> 3) + 8 * j; const LAS float* s = scr + (8 * c) * 33 + n;
        u32x4 o; o.x = pk2(s[0 * 33] * ks0.x, s[1 * 33] * ks0.y); o.y = pk2(s[2 * 33] * ks0.z, s[3 * 33] * ks0.w); o.z = pk2(s[4 * 33] * ks1.x, s[5 * 33] * ks1.y); o.w = pk2(s[6 * 33] * ks1.z, s[7 * 33] * ks1.w);
        *(u32x4*)(WT + (size_t)(dst_row0 + n0 + n) * K + k0 + 8 * c) = o; }
    asm volatile("s_waitcnt lgkmcnt(0)" ::: "memory");
}

__device__ __forceinline__ void p0_prologue(const Args& a, LAS unsigned char* lds, int wv) {
    const int tid = tid_opaque(wv), lane = tid & 63, wave = tid >> 6;
    const int gw = blockIdx.x * 8 + wave, NGW = gridDim.x * 8;
    LAS float* scr = (LAS float*)(lds + wave * 8704);
    constexpr int I_IN = 16 * 433, I_SSM = 32 * 32, I_SQ = 16 * 32, I_PW = 4 * 4 * 8, I_LAYER = I_IN + I_SSM + 3 * I_SQ + I_PW;
    for (int it = gw; it < DEPTH * I_LAYER; it += NGW) {
        const int l = it / I_LAYER; int r = it % I_LAYER;
        if (r < I_IN) { const int kb = r / 433, nb = r % 433; const int n0 = nb * 32;
            transpose_item(a.w_in + (size_t)l * 1024 * IN_COLS, 1024, IN_COLS, (bf16_t*)(a.ws + WS_WIN) + (size_t)l * NPAD * 1024, (n0 >= 4640) ? 224 : 0, a.norm_w + l * 1024, scr, kb, nb, lane); continue; }
        r -= I_IN;
        if (r < I_SSM) { transpose_item(a.w_proj_ssm + (size_t)l * 2048 * 1024, 2048, 1024, (bf16_t*)(a.ws + WS_WSSM) + (size_t)l * 1024 * 2048, 0, a.ssm_norm_w + l * 2048, scr, r / 32, r % 32, lane); continue; }
        r -= I_SSM;
        if (r < I_SQ) { transpose_item(a.w_proj_pool + (size_t)l * 1024 * 1024, 1024, 1024, (bf16_t*)(a.ws + WS_WPOOL) + (size_t)l * 1024 * 1024, 0, nullptr, scr, r / 32, r % 32, lane); continue; }
        r -= I_SQ;
        if (r < I_SQ) { transpose_item(a.w_proj_sb + (size_t)l * 1024 * 1024, 1024, 1024, (bf16_t*)(a.ws + WS_WSB) + (size_t)l * 1024 * 1024, 0, nullptr, scr, r / 32, r % 32, lane); continue; }
        r -= I_SQ;
        if (r < I_SQ) { transpose_item(a.w_out + (size_t)l * 1024 * 1024, 1024, 1024, (bf16_t*)(a.ws + WS_WOUT) + (size_t)l * 1024 * 1024, 0, nullptr, scr, r / 32, r % 32, lane); continue; }
        r -= I_SQ;
        { const int g = r / 32, rr = r % 32;
          transpose_item(a.pool_w + ((size_t)l * 4 + g) * 256 * 256, 256, 256, (bf16_t*)(a.ws + WS_PW) + (size_t)l * 1024 * 256, g * 256, nullptr, scr, rr / 8, rr % 8, lane); }
    }
    { const int gt = blockIdx.x * 512 + tid, NGT = gridDim.x * 512; constexpr int PER_L = 224 * 1024 / 8; unsigned zu = 0u; asm volatile("" : "+v"(zu));
      for (int i = gt; i < DEPTH * PER_L; i += NGT) { const int l = i / PER_L, r = i % PER_L;
          *(u32x4*)((bf16_t*)(a.ws + WS_WIN) + (size_t)l * NPAD * 1024 + (size_t)4640 * 1024 + (size_t)r * 8) = (u32x4){zu, zu, zu, zu}; } }
    for (int m0 = gw; m0 < M_ALL; m0 += 4 * NGW) {
        f32x4 v[4][4];
#pragma unroll
        for (int q = 0; q < 4; ++q)
#pragma unroll
            for (int j = 0; j < 4; ++j) v[q][j] = ((const f32x4*)(a.x + (size_t)(m0 + q * NGW) * DM) + lane)[64 * j];
#pragma unroll
        for (int q = 0; q < 4; ++q) { const int m = m0 + q * NGW; u32x2* brow = (u32x2*)((bf16_t*)(a.ws + WS_XB) + (size_t)m * DM) + lane;
            float s = 0.f;
#pragma unroll
            for (int j = 0; j < 4; ++j) { const f32x4 t = v[q][j]; s += (t.x * t.x + t.y * t.y) + (t.z * t.z + t.w * t.w); u32x2 w; w.x = pk2(t.x, t.y); w.y = pk2(t.z, t.w); brow[64 * j] = w; }
            s = wave_sum(s, lane);
            if (lane < 16) ((float*)(a.ws + WS_XSS))[(size_t)m * 16 + lane] = (lane == 0) ? s : 0.f; }
    }
}

template <int WIN> __device__ __forceinline__ void pool_item(const bf16_t* pu, bf16_t* mixed, int t0, int c0, unsigned zu) {
    constexpr int NP = WIN - 1;
    const bool first = (t0 & (SEQ - 1)) == 0;
    u32x4 raw[NP + 16];
#pragma unroll
    for (int k = 0; k < NP; ++k) raw[k] = first ? (u32x4){zu, zu, zu, zu} : *(const u32x4*)((const char*)pu + (unsigned)(((t0 - NP + k) * 1024 + c0) * 2));
#pragma unroll
    for (int i = 0; i < 16; ++i) raw[NP + i] = *(const u32x4*)((const char*)pu + (unsigned)(((t0 + i) * 1024 + c0) * 2));
    float s[8];
#pragma unroll
    for (int j = 0; j < 8; ++j) s[j] = 0.f;
#pragma unroll
    for (int k = 0; k < NP; ++k) { float v[8]; unpack8(raw[k], v);
#pragma unroll
        for (int j = 0; j < 8; ++j) s[j] += v[j]; }
#pragma unroll
    for (int i = 0; i < 16; ++i) { float cur[8], old[8], o[8]; unpack8(raw[NP + i], cur); unpack8(raw[i], old);
        const int cnt = first ? ((i + 1 < WIN) ? i + 1 : WIN) : WIN; const float inv = 1.f / (float)cnt;
#pragma unroll
        for (int j = 0; j < 8; ++j) { s[j] += cur[j]; o[j] = s[j] * inv - cur[j]; s[j] -= old[j]; }
        *(u32x4*)((char*)mixed + (unsigned)(((t0 + i) * 1024 + c0) * 2)) = pack8(o); }
}
__device__ __forceinline__ void p2a_elementwise(const Args& a, int l, int wv) {
    const int gt = blockIdx.x * 512 + tid_opaque(wv), NGT = gridDim.x * 512;
    unsigned zu = 0u; asm volatile("" : "+v"(zu));
    const bf16_t* xbc = (const bf16_t*)(a.ws + WS_XBC); bf16_t* xbcc = (bf16_t*)(a.ws + WS_XBCC);
    const float* cw = a.conv_w + (size_t)l * 4 * CONV_CH; const float* cb = a.conv_b + (size_t)l * CONV_CH;
    for (int it = gt; it < (MH / 16) * 64; it += NGT) {
        const int cgp = it & 63, tc = it >> 6, t0 = tc * 16, c0 = 2048 + cgp * 8;
        const bool first = (t0 & (SEQ - 1)) == 0;
        u32x4 raw[19];
#pragma unroll
        for (int k = 0; k < 3; ++k) raw[k] = first ? (u32x4){zu, zu, zu, zu} : *(const u32x4*)((const char*)xbc + (unsigned)(((t0 - 3 + k) * CONV_CH + c0) * 2));
#pragma unroll
        for (int i = 0; i < 16; ++i) raw[3 + i] = *(const u32x4*)((const char*)xbc + (unsigned)(((t0 + i) * CONV_CH + c0) * 2));
        float w0[8], w1[8], w2[8], w3[8], bb[8];
#pragma unroll
        for (int j = 0; j < 8; j += 4) { const f32x4 q0 = *(const f32x4*)(cw + 0 * CONV_CH + c0 + j), q1 = *(const f32x4*)(cw + 1 * CONV_CH + c0 + j), q2 = *(const f32x4*)(cw + 2 * CONV_CH + c0 + j), q3 = *(const f32x4*)(cw + 3 * CONV_CH + c0 + j), qb = *(const f32x4*)(cb + c0 + j);
#pragma unroll
            for (int e = 0; e < 4; ++e) { w0[j + e] = q0[e]; w1[j + e] = q1[e]; w2[j + e] = q2[e]; w3[j + e] = q3[e]; bb[j + e] = qb[e]; } }
        float u3[8], u2[8], u1[8];
        unpack8(raw[0], u3); unpack8(raw[1], u2); unpack8(raw[2], u1);
#pragma unroll
        for (int i = 0; i < 16; ++i) {
            float u0[8], o[8]; unpack8(raw[3 + i], u0);
#pragma unroll
            for (int j = 0; j < 8; ++j) { const float v = bb[j] + w0[j] * u3[j] + w1[j] * u2[j] + w2[j] * u1[j] + w3[j] * u0[j]; o[j] = siluf_(v); u3[j] = u2[j]; u2[j] = u1[j]; u1[j] = u0[j]; }
            *(u32x4*)((char*)xbcc + (unsigned)(((t0 + i) * CONV_CH + c0) * 2)) = pack8(o);
        }
    }
    const bf16_t* pu = (const bf16_t*)(a.ws + WS_PU); bf16_t* mixed = (bf16_t*)(a.ws + WS_MIXED);
    for (int it = gt; it < (MH / 16) * 128; it += NGT) {
        const int j64 = it & 63, grp = (it >> 6) & 3, tc2 = it >> 8;
        const int t0 = (tc2 * 2 + (j64 >> 5)) * 16, c0 = (grp * 32 + (j64 & 31)) * 8;
        if (grp == 0) pool_item<2>(pu, mixed, t0, c0, zu); else if (grp == 1) pool_item<4>(pu, mixed, t0, c0, zu); else if (grp == 2) pool_item<8>(pu, mixed, t0, c0, zu); else pool_item<16>(pu, mixed, t0, c0, zu);
    }
}

constexpr int SD_P = 272, SD_XP = 144;
constexpr int SD_XN = 0, SD_XW = SD_XN + 128 * SD_XP, SD_BN = SD_XW + 128 * SD_XP, SD_CN = SD_BN + 128 * SD_P, SD_SI = SD_CN + 128 * SD_P;
constexpr int SD_AC = SD_SI + 64 * SD_P, SD_DT = SD_AC + 8192, SD_SS = SD_DT + 8192, SD_CW = SD_SS + 2048, SD_END = SD_CW + 1280;
static_assert(SD_END <= LDS_BYTES - 16, "SSD LDS images");
__device__ __forceinline__ void tr_read4(u32x2& a, u32x2& b, u32x2& c, u32x2& d, unsigned a0, unsigned a1, unsigned a2, unsigned a3) {
    asm volatile("ds_read_b64_tr_b16 %0, %4\n\tds_read_b64_tr_b16 %1, %5\n\tds_read_b64_tr_b16 %2, %6\n\tds_read_b64_tr_b16 %3, %7\n\ts_waitcnt lgkmcnt(0)"
                 : "=&v"(a), "=&v"(b), "=&v"(c), "=&v"(d) : "v"(a0), "v"(a1), "v"(a2), "v"(a3) : "memory");
}
__device__ __forceinline__ void tr_read8(u32x2& a, u32x2& b, u32x2& c, u32x2& d, u32x2& e, u32x2& f, u32x2& g, u32x2& h, unsigned a0, unsigned a1, unsigned a2, unsigned a3, unsigned a4, unsigned a5, unsigned a6, unsigned a7) {
    asm volatile("ds_read_b64_tr_b16 %0, %8\n\tds_read_b64_tr_b16 %1, %9\n\tds_read_b64_tr_b16 %2, %10\n\tds_read_b64_tr_b16 %3, %11\n\tds_read_b64_tr_b16 %4, %12\n\tds_read_b64_tr_b16 %5, %13\n\tds_read_b64_tr_b16 %6, %14\n\tds_read_b64_tr_b16 %7, %15\n\ts_waitcnt lgkmcnt(0)"
                 : "=&v"(a), "=&v"(b), "=&v"(c), "=&v"(d), "=&v"(e), "=&v"(f), "=&v"(g), "=&v"(h) : "v"(a0), "v"(a1), "v"(a2), "v"(a3), "v"(a4), "v"(a5), "v"(a6), "v"(a7) : "memory");
}
template <bool DRY>
__device__ __forceinline__ void ssd_item(const Args& a, int l, int bl, int h, LAS unsigned char* lds, int wv) {
    const int tid = tid_opaque(wv), lane = tid & 63, wave = tid >> 6, r = lane & 31, hh = lane >> 5, pb = wave >> 2, lb = (wave & 3) ^ (pb ? 3 : 0);
    const bf16_t* xbcc = (const bf16_t*)(a.ws + WS_XBCC); const bf16_t* xbc = (const bf16_t*)(a.ws + WS_XBC); bf16_t* zs = (bf16_t*)(a.ws + WS_ZS); const float* dt = (const float*)(a.ws + WS_DT); float* ssq = (float*)(a.ws + WS_SSQ);
    const float A = -__expf(a.a_log[l * NHEAD + h]), Dh = a.d_skip[l * NHEAD + h]; const int g = h >> 4; const size_t rowbase = (size_t)bl * SEQ;
    LAS float* acum_all = (LAS float*)(lds + SD_AC); LAS float* dts_all = (LAS float*)(lds + SD_DT); LAS float* ssum = (LAS float*)(lds + SD_SS);
    const unsigned lds0 = (unsigned)(size_t)lds;
    const int trq = (lane & 15) >> 2, trp = lane & 3, trblk = (lane >> 4) & 1;
    const unsigned trx = lds0 + (unsigned)(trq * SD_XP + (32 * pb + 16 * trblk + 4 * trp) * 2);
    const unsigned trb = lds0 + (unsigned)(SD_BN + trq * SD_P + (32 * lb + 16 * trblk + 4 * trp) * 2);
    float zf = 0.f; asm volatile("" : "+v"(zf));
    __syncthreads();
    for (int i = tid; i < 64 * SD_P / 4; i += 512) ((LAS unsigned*)(lds + SD_SI))[i] = 0u;
    if (tid < 320) { const int k = tid >> 6, cc = tid & 63; ((LAS float*)(lds + SD_CW))[tid] = (k < 4) ? a.conv_w[((size_t)l * 4 + k) * CONV_CH + h * 64 + cc] : a.conv_b[(size_t)l * CONV_CH + h * 64 + cc]; }
    const unsigned xoff = (unsigned)(((tid >> 3) * CONV_CH + h * 64 + (tid & 7) * 8) * 2), boff = (unsigned)(((tid >> 4) * CONV_CH + 2048 + g * 128 + (tid & 15) * 8) * 2);
#define SSD_LOAD_X(rr0, FIRST) do { \
        _Pragma("unroll") for (int j = 0; j < 2; ++j) { const int tl = (tid >> 3) + 64 * j; \
            _Pragma("unroll") for (int k = 0; k < 4; ++k) { const char* rb_ = (const char*)(xbc + ((rr0) + 64 * j + k - 3) * CONV_CH); \
                xr[j][k] = ((FIRST) && tl + k < 3) ? (u32x4){zu, zu, zu, zu} : *(const u32x4*)(rb_ + xoff); } } \
        } while (0)
#define SSD_LOAD_BC(rr0) do { \
        _Pragma("unroll") for (int j = 0; j < 4; ++j) { const char* rb_ = (const char*)(xbcc + ((rr0) + 32 * j) * CONV_CH); br[j] = *(const u32x4*)(rb_ + boff); cr[j] = *(const u32x4*)(rb_ + boff + 512); } \
        } while (0)
    unsigned zu = 0u; asm volatile("" : "+v"(zu));
    u32x4 xr[2][4], br[4], cr[4];
    SSD_LOAD_X(rowbase, true); SSD_LOAD_BC(rowbase);
    { float dv[4];
#pragma unroll
      for (int q = 0; q < 4; ++q) dv[q] = dt[(rowbase + (size_t)(wave * 256 + q * 64 + lane)) * 32 + h];
#pragma unroll
      for (int q = 0; q < 4; ++q) { float sv = dv[q] * A;
#pragma unroll
          for (int o = 1; o < 64; o <<= 1) { const float t = __int_as_float(__builtin_amdgcn_ds_bpermute(((lane - o) & 63) << 2, __float_as_int(sv))); sv += (lane >= o) ? t : 0.f; }
          acum_all[wave * 256 + q * 64 + lane] = sv; dts_all[wave * 256 + q * 64 + lane] = dv[q]; }
      asm volatile("s_waitcnt lgkmcnt(0)" ::: "memory");
#pragma unroll
      for (int q = 1; q < 4; q += 2) { const float tot = acum_all[wave * 256 + (q - 1) * 64 + 63]; acum_all[wave * 256 + q * 64 + lane] += tot; } }
    f32x16 sacc;
#pragma unroll
    for (int i = 0; i < 16; ++i) sacc[i] = zf;
#pragma unroll 1
    for (int c = 0; c < SEQ / 128; ++c) {
        const size_t r0 = rowbase + (size_t)c * 128;
        const LAS float* acum = acum_all + c * 128; const LAS float* dts = dts_all + c * 128;
        __syncthreads();
        const float a_end = acum[127];
#pragma unroll
        for (int j = 0; j < 2; ++j) { const int idx = tid + 512 * j, tl = idx >> 3, c8 = (idx & 7) * 8; const float w = dts[tl] * __expf(a_end - acum[tl]);
            float u3[8], u2[8], u1[8], u0[8], f[8]; unpack8(xr[j][0], u3); unpack8(xr[j][1], u2); unpack8(xr[j][2], u1); unpack8(xr[j][3], u0);
            const LAS float* cwl = (const LAS float*)(lds + SD_CW) + c8;
#pragma unroll
            for (int i = 0; i < 8; i += 4) { const f32x4 q0 = *(const LAS f32x4*)(cwl + i), q1 = *(const LAS f32x4*)(cwl + 64 + i), q2 = *(const LAS f32x4*)(cwl + 128 + i), q3 = *(const LAS f32x4*)(cwl + 192 + i), qb = *(const LAS f32x4*)(cwl + 256 + i);
#pragma unroll
                for (int e = 0; e < 4; ++e) f[i + e] = siluf_(qb[e] + q0[e] * u3[i + e] + q1[e] * u2[i + e] + q2[e] * u1[i + e] + q3[e] * u0[i + e]); }
            *(LAS u32x4*)(lds + SD_XN + tl * SD_XP + c8 * 2) = pack8(f);
#pragma unroll
            for (int i = 0; i < 8; ++i) f[i] *= w;
            *(LAS u32x4*)(lds + SD_XW + tl * SD_XP + c8 * 2) = pack8(f); }
#pragma unroll
        for (int j = 0; j < 4; ++j) { const int idx = tid + 512 * j, tl = idx >> 4, n8 = (idx & 15) * 8; *(LAS u32x4*)(lds + SD_BN + tl * SD_P + n8 * 2) = br[j]; *(LAS u32x4*)(lds + SD_CN + tl * SD_P + n8 * 2) = cr[j]; }
        __syncthreads();
        if (c + 1 < SEQ / 128) SSD_LOAD_X(r0 + 128, false);
        {
            const int lrow = 32 * lb + r; const float acl = acum[lrow];
            const size_t row = r0 + lrow; u32x2 zw4[4];
#pragma unroll
            for (int g4 = 0; g4 < 4; ++g4) { const int p0 = 32 * pb + 8 * g4 + 4 * hh; zw4[g4] = *(const u32x2*)(zs + row * SSM_W + h * 64 + p0); }
            bf16x8 cf[8];
#pragma unroll
            for (int ks = 0; ks < 8; ++ks) cf[ks] = *(const LAS bf16x8*)(lds + SD_CN + lrow * SD_P + (16 * ks + 8 * hh) * 2);
            f32x16 acc;
#pragma unroll
            for (int i = 0; i < 16; ++i) acc[i] = zf;
#pragma unroll
            for (int ks = 0; ks < 8; ++ks) { const bf16x8 af = *(const LAS bf16x8*)(lds + SD_SI + (32 * pb + r) * SD_P + (16 * ks + 8 * hh) * 2); acc = MFMA32(af, cf[ks], acc); }
            { const float el = __expf(acl);
#pragma unroll
              for (int i = 0; i < 16; ++i) acc[i] *= el; }
#pragma unroll 1
            for (int sb = 0; sb <= lb; ++sb) {
                f32x16 cb;
#pragma unroll
                for (int i = 0; i < 16; ++i) cb[i] = zf;
#pragma unroll
                for (int ks = 0; ks < 8; ++ks) { const bf16x8 bfr = *(const LAS bf16x8*)(lds + SD_BN + (32 * sb + r) * SD_P + (16 * ks + 8 * hh) * 2); cb = MFMA32(bfr, cf[ks], cb); }
                u32x2 x0l, x0h, x1l, x1h;
                { const unsigned xa = trx + (unsigned)(SD_XN + (32 * sb + 4 * hh) * SD_XP); tr_read4(x0l, x0h, x1l, x1h, xa, xa + 8 * SD_XP, xa + 16 * SD_XP, xa + 24 * SD_XP); }
                float m[16];
#pragma unroll
                for (int g4 = 0; g4 < 4; ++g4) { const f32x4 as = *(const LAS f32x4*)(acum + 32 * sb + 8 * g4 + 4 * hh), ds = *(const LAS f32x4*)(dts + 32 * sb + 8 * g4 + 4 * hh);
#pragma unroll
                    for (int j = 0; j < 4; ++j) m[4 * g4 + j] = cb[4 * g4 + j] * __expf(acl - as[j]) * ds[j]; }
                if (sb == lb) {
#pragma unroll
                    for (int i = 0; i < 16; ++i) { const bool valid = ((i & 3) + 8 * (i >> 2) + 4 * hh) <= r; m[i] = valid ? m[i] : 0.f; }
                }
                u32x4 pw0, pw1;
                pw0.x = pk2(m[0], m[1]); pw0.y = pk2(m[2], m[3]); pw0.z = pk2(m[4], m[5]); pw0.w = pk2(m[6], m[7]);
                pw1.x = pk2(m[8], m[9]); pw1.y = pk2(m[10], m[11]); pw1.z = pk2(m[12], m[13]); pw1.w = pk2(m[14], m[15]);
                acc = MFMA32(__builtin_bit_cast(bf16x8, (u32x4){x0l.x, x0l.y, x0h.x, x0h.y}), __builtin_bit_cast(bf16x8, pw0), acc);
                acc = MFMA32(__builtin_bit_cast(bf16x8, (u32x4){x1l.x, x1l.y, x1h.x, x1h.y}), __builtin_bit_cast(bf16x8, pw1), acc);
            }
            if (c + 1 < SEQ / 128) SSD_LOAD_BC(r0 + 128);
            float ss = 0.f;
#pragma unroll
            for (int g4 = 0; g4 < 4; ++g4) { const int p0 = 32 * pb + 8 * g4 + 4 * hh;
                const u32x2 xw = *(const LAS u32x2*)(lds + SD_XN + lrow * SD_XP + p0 * 2), zw = zw4[g4];
                const float y0 = (acc[4 * g4] + Dh * bflo(xw.x)) * siluf_(bflo(zw.x)), y1 = (acc[4 * g4 + 1] + Dh * bfhi(xw.x)) * siluf_(bfhi(zw.x)), y2 = (acc[4 * g4 + 2] + Dh * bflo(xw.y)) * siluf_(bflo(zw.y)), y3 = (acc[4 * g4 + 3] + Dh * bfhi(xw.y)) * siluf_(bfhi(zw.y));
                ss += (y0 * y0 + y1 * y1) + (y2 * y2 + y3 * y3);
                u32x2 w; w.x = pk2(y0, y1); w.y = pk2(y2, y3); if (!DRY) *(u32x2*)(zs + row * SSM_W + h * 64 + p0) = w; }
            ssum[(pb * 2 + hh) * 128 + lrow] = ss;
        }
        __syncthreads();
        if (!DRY && tid < 128) ssq[(r0 + tid) * 32 + h] = (ssum[tid] + ssum[128 + tid]) + (ssum[256 + tid] + ssum[384 + tid]);
        { const float dec = __expf(a_end);
#pragma unroll
          for (int i = 0; i < 16; ++i) sacc[i] *= dec;
#pragma unroll
          for (int ks = 0; ks < 8; ++ks) { u32x2 bl_, bh_, xl_, xh_;
              const unsigned ba = trb + (unsigned)((16 * ks + 8 * hh) * SD_P), xa = trx + (unsigned)(SD_XW + (16 * ks + 8 * hh) * SD_XP);
              tr_read4(bl_, bh_, xl_, xh_, ba, ba + 4 * SD_P, xa, xa + 4 * SD_XP);
              sacc = MFMA32(__builtin_bit_cast(bf16x8, (u32x4){bl_.x, bl_.y, bh_.x, bh_.y}), __builtin_bit_cast(bf16x8, (u32x4){xl_.x, xl_.y, xh_.x, xh_.y}), sacc); }
#pragma unroll
          for (int g4 = 0; g4 < 4; ++g4) { u32x2 w; w.x = pk2(sacc[4 * g4], sacc[4 * g4 + 1]); w.y = pk2(sacc[4 * g4 + 2], sacc[4 * g4 + 3]);
              *(LAS u32x2*)(lds + SD_SI + (32 * pb + r) * SD_P + (32 * lb + 8 * g4 + 4 * hh) * 2) = w; } }
    }
#undef SSD_LOAD_X
#undef SSD_LOAD_BC
    __syncthreads();
}

constexpr int SB_KST = 144, SB_VST = 144;
constexpr int SB_KBUF = 64 * SB_KST, SB_VBUF = 64 * SB_VST;
__device__ __forceinline__ void sb_item(const Args& a, int bl, int hp, int qb, LAS unsigned char* lds, int wv) {
    const int tid = tid_opaque(wv), lane = tid & 63, wave = tid >> 6, r = lane & 31, hh = lane >> 5, grp = wave >> 2, h = hp * 2 + grp;
    const size_t rowbase = (size_t)bl * SEQ;
    const bf16_t* qkv = (const bf16_t*)(a.ws + WS_QKV); const bf16_t* sg = (const bf16_t*)(a.ws + WS_SG); bf16_t* sbo = (bf16_t*)(a.ws + WS_SBO);
    const int qw0 = qb * 128 + ((wave & 3) ^ (grp ? 3 : 0)) * 32, tq = qw0 + r;
    bf16x8 qf[4];
#pragma unroll
    for (int s = 0; s < 4; ++s) qf[s] = *(const bf16x8*)(qkv + (rowbase + tq) * 3072 + h * 64 + 16 * s + 8 * hh);
    float zf = 0.f; asm volatile("" : "+v"(zf));
    f32x16 o0, o1;
#pragma unroll
    for (int i = 0; i < 16; ++i) { o0[i] = zf; o1[i] = zf; }
    float carry = 1.f + zf;
    const int tg = tid & 255, kk = tg >> 3, c8 = (tg & 7) * 8;
    const int ntile = qb * 2 + 2;
    constexpr int SB_GRP = 2 * SB_KBUF + 2 * SB_VBUF;
    LAS unsigned char* gl = lds + grp * SB_GRP;
    const bf16_t* kg = qkv + rowbase * 3072 + 1024 + h * 64 + c8; const bf16_t* vg = qkv + rowbase * 3072 + 2048 + h * 64 + c8;
    u32x4 kreg[2], vreg[2];
#define SB_LOAD(t_) do { _Pragma("unroll") for (int j_ = 0; j_ < 2; ++j_) { kreg[j_] = *(const u32x4*)(kg + (size_t)((t_) * 64 + kk + 32 * j_) * 3072); vreg[j_] = *(const u32x4*)(vg + (size_t)((t_) * 64 + kk + 32 * j_) * 3072); } } while (0)
#define SB_STAGE(buf) do { LAS unsigned char* kb_ = gl + (buf) * SB_KBUF; LAS unsigned char* vb_ = gl + 2 * SB_KBUF + (buf) * SB_VBUF; \
        _Pragma("unroll") for (int j_ = 0; j_ < 2; ++j_) { *(LAS u32x4*)(kb_ + (kk + 32 * j_) * SB_KST + c8 * 2) = kreg[j_]; \
        *(LAS u32x4*)(vb_ + (kk + 32 * j_) * SB_VST + c8 * 2) = vreg[j_]; } } while (0)
    SB_LOAD(ntile - 1);
    LAS unsigned* flags = (LAS unsigned*)(lds + 2 * SB_GRP);
    __syncthreads();
    SB_STAGE(0);
    __syncthreads();
    int cur = 0; bool wdone = false;
    for (int tile = ntile - 1; tile >= 0; --tile) {
        const int k0 = tile * 64;
        if (tile > 0) SB_LOAD(tile - 1);
        if (k0 <= qw0 && !wdone) {
            const LAS unsigned char* kc = gl + cur * SB_KBUF; const LAS unsigned char* vc = gl + 2 * SB_KBUF + cur * SB_VBUF;
#pragma unroll 1
            for (int kb = 1; kb >= 0; --kb) {
                const int kbase = k0 + 32 * kb;
                if (kbase > qw0) continue;
                f32x16 sacc;
#pragma unroll
                for (int i = 0; i < 16; ++i) sacc[i] = zf;
#pragma unroll
                for (int s = 0; s < 4; ++s) { const bf16x8 kf = *(const LAS bf16x8*)(kc + (32 * kb + r) * SB_KST + (16 * s + 8 * hh) * 2); sacc = MFMA32(kf, qf[s], sacc); }
                u32x2 v00l, v00h, v01l, v01h, v10l, v10h, v11l, v11h;
                { const unsigned va = (unsigned)(size_t)vc + (unsigned)((32 * kb + 4 * hh + ((lane & 15) >> 2)) * SB_VST + (16 * ((lane >> 4) & 1) + 4 * (lane & 3)) * 2);
                  tr_read8(v00l, v00h, v01l, v01h, v10l, v10h, v11l, v11h, va, va + 8 * SB_VST, va + 64, va + 64 + 8 * SB_VST, va + 16 * SB_VST, va + 24 * SB_VST, va + 64 + 16 * SB_VST, va + 64 + 24 * SB_VST); }
                float bt[16], om[16];
#pragma unroll
                for (int i = 0; i < 16; ++i) { const float e = __builtin_amdgcn_exp2f(-__builtin_amdgcn_fmed3f(sacc[i], -126.f, 126.f)); bt[i] = __builtin_amdgcn_rcpf(1.f + e); om[i] = e * bt[i]; }
                if (kbase == qw0) {
#pragma unroll
                    for (int i = 0; i < 16; ++i) { const bool valid = ((i & 3) + 8 * (i >> 2) + 4 * hh) < r; om[i] = valid ? om[i] : 1.f; bt[i] = valid ? bt[i] : 0.f; }
                }
                float ex[16], T[4], PT[4];
#pragma unroll
                for (int g = 0; g < 4; ++g) { ex[4 * g + 3] = 1.f; ex[4 * g + 2] = om[4 * g + 3]; ex[4 * g + 1] = ex[4 * g + 2] * om[4 * g + 2]; ex[4 * g] = ex[4 * g + 1] * om[4 * g + 1]; T[g] = ex[4 * g] * om[4 * g]; }
#pragma unroll
                for (int g = 0; g < 4; ++g) PT[g] = shx(T[g], 32, lane);
                const float W0 = T[0] * PT[0], W1 = T[1] * PT[1], W2 = T[2] * PT[2], W3 = T[3] * PT[3];
                float base[4];
                base[3] = carry; base[2] = carry * W3; base[1] = base[2] * W2; base[0] = base[1] * W1;
                carry = base[0] * W0;
                if (hh == 0) {
#pragma unroll
                    for (int g = 0; g < 4; ++g) base[g] *= PT[g];
                }
                float p[16];
#pragma unroll
                for (int i = 0; i < 16; ++i) p[i] = bt[i] * (base[i >> 2] * ex[i]);
                u32x4 pw0, pw1;
                pw0.x = pk2(p[0], p[1]); pw0.y = pk2(p[2], p[3]); pw0.z = pk2(p[4], p[5]); pw0.w = pk2(p[6], p[7]);
                pw1.x = pk2(p[8], p[9]); pw1.y = pk2(p[10], p[11]); pw1.z = pk2(p[12], p[13]); pw1.w = pk2(p[14], p[15]);
                const bf16x8 pf0 = __builtin_bit_cast(bf16x8, pw0), pf1 = __builtin_bit_cast(bf16x8, pw1);
                o0 = MFMA32(__builtin_bit_cast(bf16x8, (u32x4){v00l.x, v00l.y, v00h.x, v00h.y}), pf0, o0); o1 = MFMA32(__builtin_bit_cast(bf16x8, (u32x4){v01l.x, v01l.y, v01h.x, v01h.y}), pf0, o1);
                o0 = MFMA32(__builtin_bit_cast(bf16x8, (u32x4){v10l.x, v10l.y, v10h.x, v10h.y}), pf1, o0); o1 = MFMA32(__builtin_bit_cast(bf16x8, (u32x4){v11l.x, v11l.y, v11h.x, v11h.y}), pf1, o1);
            }
        }
        wdone = (__builtin_amdgcn_ballot_w64(carry != 0.f) == 0ull);
        if (lane == 0) flags[(tile & 1) * 8 + wave] = wdone ? 1u : 0u;
        if (tile > 0) SB_STAGE(cur ^ 1);
        __syncthreads();
        cur ^= 1;
        { const LAS u32x4* fp = (const LAS u32x4*)(flags + (tile & 1) * 8); const u32x4 f0 = fp[0], f1 = fp[1];
          if ((f0.x & f0.y & f0.z & f0.w & f1.x & f1.y & f1.z & f1.w) != 0u) break; }
    }
#undef SB_STAGE
#undef SB_LOAD
    u32x2 gwv[2][4];
#pragma unroll
    for (int dblk = 0; dblk < 2; ++dblk)
#pragma unroll
        for (int g = 0; g < 4; ++g) gwv[dblk][g] = *(const u32x2*)(sg + (rowbase + tq) * 1024 + h * 64 + 32 * dblk + 8 * g + 4 * hh);
    __builtin_amdgcn_sched_barrier(0);
#pragma unroll
    for (int dblk = 0; dblk < 2; ++dblk)
#pragma unroll
        for (int g = 0; g < 4; ++g) { const size_t off = (rowbase + tq) * 1024 + h * 64 + 32 * dblk + 8 * g + 4 * hh; const u32x2 gw = gwv[dblk][g];
            const float v0 = (dblk ? o1[4 * g] : o0[4 * g]) * siluf_(bflo(gw.x)), v1 = (dblk ? o1[4 * g + 1] : o0[4 * g + 1]) * siluf_(bfhi(gw.x)), v2 = (dblk ? o1[4 * g + 2] : o0[4 * g + 2]) * siluf_(bflo(gw.y)), v3 = (dblk ? o1[4 * g + 3] : o0[4 * g + 3]) * siluf_(bfhi(gw.y));
            u32x2 w; w.x = pk2(v0, v1); w.y = pk2(v2, v3); *(u32x2*)(sbo + off) = w; }
    __syncthreads();
}

__device__ __forceinline__ void final_norm(const Args& a, int wv) {
    const int tid = tid_opaque(wv), lane = tid & 63, gw = blockIdx.x * 8 + (tid >> 6), NGW = gridDim.x * 8;
    const float* xss = (const float*)(a.ws + WS_XSS);
    f32x4 wn[4];
#pragma unroll
    for (int j = 0; j < 4; ++j) wn[j] = ((const f32x4*)a.final_norm_w + lane)[64 * j];
    for (int m0 = gw; m0 < M_ALL; m0 += 4 * NGW) {
        f32x4 v[4][4]; float sp[4];
#pragma unroll
        for (int q = 0; q < 4; ++q) { const int m = m0 + q * NGW; sp[q] = (lane < 16) ? xss[(size_t)m * 16 + lane] : 0.f;
#pragma unroll
            for (int j = 0; j < 4; ++j) v[q][j] = ((const f32x4*)(a.out + (size_t)m * DM) + lane)[64 * j]; }
#pragma unroll
        for (int q = 0; q < 4; ++q) { const int m = m0 + q * NGW; const float r = 1.f / sqrtf(wave_sum(sp[q], lane) * (1.f / DM) + EPS);
#pragma unroll
            for (int j = 0; j < 4; ++j) ((f32x4*)(a.out + (size_t)m * DM) + lane)[64 * j] = v[q][j] * r * wn[j]; }
    }
}

constexpr int N_PHASES = 1 + DEPTH * 2 * 5 + 1;

__global__ void __launch_bounds__(512, 2) mega(Args a0) {
    extern __shared__ __attribute__((aligned(16))) unsigned char lds_raw[];
    LAS unsigned char* lds = (LAS unsigned char*)lds_raw;
    const int G = gridDim.x, bx = blockIdx.x;
    const int wv = __builtin_amdgcn_readfirstlane((int)(threadIdx.x >> 6));
    volatile LAS unsigned* bst = (volatile LAS unsigned*)(lds + LDS_BYTES - 16);
    if (threadIdx.x < 4) bst[threadIdx.x] = 0u;
    __syncthreads();
    const XcdBarrier xbar = xcd_barrier_post((unsigned*)(a0.ws + WS_BAR), bst, threadIdx.x == 0);
    for (int ph = a0.ph_lo; ph < a0.ph_hi; ++ph) {
        Args a = a0;
        long zo = 0; asm volatile("" : "+s"(zo));
        a.x += zo; a.norm_w += zo; a.w_in += zo; a.conv_w += zo; a.conv_b += zo; a.dt_bias += zo; a.a_log += zo; a.d_skip += zo; a.ssm_norm_w += zo; a.pool_w += zo; a.pool_scale += zo;
        a.w_proj_ssm += zo; a.w_proj_pool += zo; a.w_proj_sb += zo; a.w_out += zo; a.final_norm_w += zo; a.out += zo; a.ws += zo;
        if (ph == 0) p0_prologue(a, lds, wv);
        else if (ph == N_PHASES - 1) final_norm(a, wv);
        else {
            const int q = ph - 1, l = q / 10, hf = (q % 10) / 5, k = q % 5;
            unsigned char* ws = a.ws;
            if (k == 1) {
                p2a_elementwise(a, l, wv);
            } else if (k == 2) {
                { pg8::Gemm g{(const bf16_t*)(ws + WS_MIXED), (const bf16_t*)(ws + WS_PW) + (size_t)l * 1024 * 256};
                  pg8::StaticOrder S; S.init(MH, 1024, G, bx);
                  EpiPool E{ws, a.pool_scale + l * 1024};
                  pg8::gemm_phase<EpiPool, 1024, 256, 256, 256>(lds, g, S, E, wv);
                }
                for (int it0 = bx; it0 < 8 * NHEAD; it0 += G) { int it = it0;
                    if (G == 256) { const int xcd = it0 & 7, slot = it0 >> 3, grp16 = xcd * 2 + (slot >> 4); it = (grp16 >> 1) * NHEAD + (grp16 & 1) * 16 + (slot & 15); }
                    ssd_item<false>(a, l, it / NHEAD, it % NHEAD, lds, wv); }
                for (int it0 = bx; it0 < 8 * 8 * 4; it0 += G) { int it = it0;
                    if (G == 256) { const int xcd = it0 & 7, slot = it0 >> 3; it = ((xcd * 8 + (slot >> 2)) << 2) | (slot & 3); }
                    const int bhp = it >> 2, sel = it & 3;
#pragma unroll 1
                    for (int j = 0; j < 4; ++j) { const int qbk = (j == 0) ? 15 - sel : (j == 1) ? sel : (j == 2) ? 8 + sel : 7 - sel; sb_item(a, bhp >> 3, bhp & 7, qbk, lds, wv); } }
            } else {
                const int nsub = (k == 3) ? 3 : 1;
#pragma unroll 1
                for (int sub = 0; sub < nsub; ++sub) {
                    if (k == 3 && sub == 0) {
                        pg8::StaticOrder S; S.init(MH, 1024, G, bx);
                        pg8::Gemm g{(const bf16_t*)(ws + WS_ZS), (const bf16_t*)(ws + WS_WSSM) + (size_t)l * 1024 * 2048};
                        p3_rstd((const float*)(ws + WS_SSQ), S, (LAS float*)(lds + RS_OFF), wv);
                        EpiMerge<0> E{ws, (const LAS float*)(lds + RS_OFF)};
                        pg8::gemm_phase<EpiMerge<0>, 2048, 2048, 2048, 0>(lds, g, S, E, wv);
                    } else {
                        const int mode = (k == 0) ? 0 : (k == 4) ? 3 : sub;
                        pg8::StaticOrder S; S.init(MH, mode == 0 ? NPAD : 1024, G, bx, mode == 0 ? P1_WGM : pg8::WGM);
                        const bf16_t* Ap = (mode == 0) ? (const bf16_t*)(ws + WS_XB) + (size_t)hf * MH * DM : (mode == 1) ? (const bf16_t*)(ws + WS_PU) : (mode == 2) ? (const bf16_t*)(ws + WS_SBO) : (const bf16_t*)(ws + WS_MB);
                        const bf16_t* Bp = (mode == 0) ? (const bf16_t*)(ws + WS_WIN) + (size_t)l * NPAD * 1024 : (const bf16_t*)(ws + (mode == 1 ? WS_WPOOL : mode == 2 ? WS_WSB : WS_WOUT)) + (size_t)l * 1024 * 1024;
                        pg8::Gemm g{Ap, Bp};
                        if (mode == 0) p1_rstd((const float*)(ws + WS_XSS) + (size_t)hf * MH * 16, S, (LAS float*)(lds + RS_OFF), wv);
                        EpiMulti E{mode, {(const LAS float*)(lds + RS_OFF), ws, a.dt_bias + l * NHEAD}, {ws, nullptr}, {ws, nullptr},
                                   {(l == 0 ? a.x : (const float*)a.out) + (size_t)hf * MH * DM, a.out + (size_t)hf * MH * DM, (l == DEPTH - 1) ? (bf16_t*)nullptr : (bf16_t*)(ws + WS_XB) + (size_t)hf * MH * DM, (float*)(ws + WS_XSS) + (size_t)hf * MH * 16}};
                        pg8::gemm_phase<EpiMulti, 1024, 1024, 1024, 0>(lds, g, S, E, wv);
                    }
                }
            }
        }
        if (ph + 1 < a0.ph_hi) { if (ph == a0.ph_lo) cg::this_grid().sync(); else xcd_barrier(xbar, tid_opaque(wv) == 0); }
    }
}

extern "C" void kernel_launch(void* const* d_in, const int* in_sizes, int n_in, void* d_out, int out_size, void* d_ws, size_t ws_size, hipStream_t stream) {
    static int grid = 0;
    if (grid == 0) {
        if (ws_size < WS_END) { fprintf(stderr, "kernel_launch: workspace too small: %zu < %zu\n", ws_size, (size_t)WS_END); grid = -1; return; }
        int dev = 0, cus = 0, per_cu = 0;
        hipGetDevice(&dev); hipDeviceGetAttribute(&cus, hipDeviceAttributeMultiprocessorCount, dev);
        if (hipFuncSetAttribute((const void*)mega, hipFuncAttributeMaxDynamicSharedMemorySize, LDS_BYTES) != hipSuccess) { fprintf(stderr, "kernel_launch: hipFuncSetAttribute failed\n"); grid = -1; return; }
        if (hipOccupancyMaxActiveBlocksPerMultiprocessor(&per_cu, (const void*)mega, 512, LDS_BYTES) != hipSuccess || per_cu < 1) { fprintf(stderr, "kernel_launch: occupancy query says %d\n", per_cu); per_cu = 1; }
        (void)hipGetLastError();
        grid = cus * 1;
        if (grid <= 0) grid = 256;
    }
    if (grid < 0) return;
    (void)hipMemsetAsync((unsigned char*)d_ws + WS_BAR, 0, WS_BAR_BYTES, stream);
    Args a{};
    a.x = (const float*)d_in[0]; a.norm_w = (const float*)d_in[1]; a.w_in = (const float*)d_in[2]; a.conv_w = (const float*)d_in[3]; a.conv_b = (const float*)d_in[4];
    a.dt_bias = (const float*)d_in[5]; a.a_log = (const float*)d_in[6]; a.d_skip = (const float*)d_in[7]; a.ssm_norm_w = (const float*)d_in[8]; a.pool_w = (const float*)d_in[9];
    a.pool_scale = (const float*)d_in[10]; a.w_proj_ssm = (const float*)d_in[11]; a.w_proj_pool = (const float*)d_in[12]; a.w_proj_sb = (const float*)d_in[13]; a.w_out = (const float*)d_in[14];
    a.final_norm_w = (const float*)d_in[15]; a.out = (float*)d_out; a.ws = (unsigned char*)d_ws;
#if N_LAUNCH_MODE == 1
    a.ph_lo = 0; a.ph_hi = N_PHASES;
    void* args[] = {&a};
    hipError_t e = hipLaunchCooperativeKernel((const void*)mega, dim3(grid), dim3(512), args, LDS_BYTES, stream);
    if (e != hipSuccess) fprintf(stderr, "cooperative launch failed: %s (grid %d)\n", hipGetErrorString(e), grid);
#else
    for (int ph = 0; ph < N_PHASES; ++ph) { a.ph_lo = ph; a.ph_hi = ph + 1; hipLaunchKernelGGL(mega, dim3(grid), dim3(512), LDS_BYTES, stream, a); }
#endif
}
```

```cpp
#include <hip/hip_runtime.h>
#include <hip/hip_cooperative_groups.h>
#include <cstdio>
#include <cstdint>
namespace cg = cooperative_groups;

#ifndef P1_WGM
#define P1_WGM 4
#endif
#ifndef N_LAUNCH_MODE
#define N_LAUNCH_MODE 1
#endif

#define LAS __attribute__((address_space(3)))
typedef unsigned short bf16_t;
typedef short bf16x8 __attribute__((ext_vector_type(8)));
typedef float f32x4 __attribute__((ext_vector_type(4)));
typedef unsigned u32x4 __attribute__((ext_vector_type(4)));
typedef unsigned u32x2 __attribute__((ext_vector_type(2)));

constexpr int DM = 1024, BATCH = 16, SEQ = 2048, DEPTH = 4;
constexpr int M_ALL = BATCH * SEQ;
constexpr int MH = M_ALL / 2;
constexpr int SSM_W = 2048, NHEAD = 32, CONV_CH = 2560, IN_COLS = 13856, NPAD = 14080;
constexpr float EPS = 1e-6f;

constexpr size_t al256(size_t x) { return (x + 255) & ~(size_t)255; }
constexpr size_t WS_WIN   = 0;
constexpr size_t WS_WSSM  = WS_WIN   + (size_t)DEPTH * NPAD * 1024 * 2;
constexpr size_t WS_WPOOL = WS_WSSM  + (size_t)DEPTH * 1024 * 2048 * 2;
constexpr size_t WS_WSB   = WS_WPOOL + (size_t)DEPTH * 1024 * 1024 * 2;
constexpr size_t WS_WOUT  = WS_WSB   + (size_t)DEPTH * 1024 * 1024 * 2;
constexpr size_t WS_PW    = WS_WOUT  + (size_t)DEPTH * 1024 * 1024 * 2;
constexpr size_t WS_XB    = WS_PW    + (size_t)DEPTH * 1024 * 256 * 2;
constexpr size_t WS_XSS   = WS_XB    + (size_t)M_ALL * 1024 * 2;
constexpr size_t WS_ZS    = WS_XSS   + (size_t)M_ALL * 16 * 4;
constexpr size_t WS_XBC   = WS_ZS    + (size_t)MH * 2048 * 2;
constexpr size_t WS_DT    = WS_XBC   + (size_t)MH * 2560 * 2;
constexpr size_t WS_PU    = WS_DT    + (size_t)MH * 32 * 4;
constexpr size_t WS_PG    = WS_PU    + (size_t)MH * 1024 * 2;
constexpr size_t WS_QKV   = WS_PG    + (size_t)MH * 1024 * 2;
constexpr size_t WS_SG    = WS_QKV   + (size_t)MH * 3072 * 2;
constexpr size_t WS_MG    = WS_SG    + (size_t)MH * 1024 * 2;
constexpr size_t WS_XBCC  = WS_MG    + (size_t)MH * 3072 * 2;
constexpr size_t WS_MACC  = WS_XBCC;
constexpr size_t WS_MIXED = WS_XBCC  + (size_t)MH * 2560 * 2;
constexpr size_t WS_MB    = WS_MIXED;
constexpr size_t WS_SBO   = WS_MIXED + (size_t)MH * 1024 * 2;
constexpr size_t WS_SSQ   = WS_SBO   + (size_t)MH * 1024 * 2;
constexpr size_t WS_BAR   = WS_SSQ   + (size_t)MH * 32 * 4;
constexpr size_t WS_BAR_BYTES = 16384;
constexpr size_t WS_END   = WS_BAR   + WS_BAR_BYTES;

constexpr int LDS_BYTES = 147456;
constexpr int RS_OFF = 131072;

typedef float f32x2 __attribute__((ext_vector_type(2)));
typedef __bf16 bf2_t __attribute__((ext_vector_type(2)));
typedef float f32x16 __attribute__((ext_vector_type(16)));
__device__ __forceinline__ unsigned pk2(float lo, float hi) { const bf2_t v = __builtin_convertvector((f32x2){lo, hi}, bf2_t); return __builtin_bit_cast(unsigned, v); }
#define MFMA32(a, b, c) __builtin_amdgcn_mfma_f32_32x32x16_bf16((a), (b), (c), 0, 0, 0)
__device__ __forceinline__ float bflo(unsigned u) { return __uint_as_float(u << 16); }
__device__ __forceinline__ float bfhi(unsigned u) { return __uint_as_float(u & 0xffff0000u); }
__device__ __forceinline__ void unpack8(const u32x4 w, float (&f)[8]) {
    f[0] = bflo(w.x); f[1] = bfhi(w.x); f[2] = bflo(w.y); f[3] = bfhi(w.y); f[4] = bflo(w.z); f[5] = bfhi(w.z); f[6] = bflo(w.w); f[7] = bfhi(w.w);
}
__device__ __forceinline__ u32x4 pack8(const float (&f)[8]) { u32x4 w; w.x = pk2(f[0], f[1]); w.y = pk2(f[2], f[3]); w.z = pk2(f[4], f[5]); w.w = pk2(f[6], f[7]); return w; }
__device__ __forceinline__ float sigmoidf_(float v) { return __builtin_amdgcn_rcpf(1.f + __expf(-v)); }
__device__ __forceinline__ float siluf_(float v) { return v * sigmoidf_(v); }
__device__ __forceinline__ float shx(float v, int mask, int lane) { return __int_as_float(__builtin_amdgcn_ds_bpermute((lane ^ mask) << 2, __float_as_int(v))); }
__device__ __forceinline__ float wave_sum(float v, int lane) {
#pragma unroll
    for (int o = 1; o < 64; o <<= 1) v += shx(v, o, lane);
    return v;
}

__device__ __forceinline__ int tid_opaque(int wv) { int t = wv * 64 + (int)__builtin_amdgcn_mbcnt_hi(~0u, __builtin_amdgcn_mbcnt_lo(~0u, 0u)); asm volatile("" : "+v"(t)); return t; }

#define XB_TMO      128
#define XB_XCNT(j)  (256  + 64 * (j))
#define XB_XSUB(j)  (1280 + 64 * (j))
#define XB_XGEN(j)  (2304 + 64 * (j))
#define XB_TOP      3328
#define XB_TOPGEN   3392
#define XCD_BAR_WORDS 3456
#define XB_SPIN_CAP (1u << 18)

__device__ __forceinline__ unsigned xb_ld(unsigned* p)              { return __hip_atomic_load(p, __ATOMIC_RELAXED, __HIP_MEMORY_SCOPE_AGENT); }
__device__ __forceinline__ unsigned xb_add(unsigned* p, unsigned v) { return __hip_atomic_fetch_add(p, v, __ATOMIC_RELAXED, __HIP_MEMORY_SCOPE_AGENT); }
__device__ __forceinline__ unsigned xb_xcc_id() { return (unsigned)__builtin_amdgcn_s_getreg((3 << 11) | 20) & 0xFu; }
#define XB_SPIN(cond, bar) do { unsigned _sp = 0; while (cond) { __builtin_amdgcn_s_sleep(1); \
    if ((++_sp & 255u) == 0u) { if (xb_ld(&(bar)[XB_TMO])) break; if (_sp > XB_SPIN_CAP) { atomicAdd(&(bar)[XB_TMO], 1u); break; } } } } while (0)

struct XcdBarrier {
    unsigned* bar; unsigned x;
    volatile LAS unsigned* st;
};

__device__ __forceinline__ XcdBarrier xcd_barrier_post(unsigned* bar, volatile LAS unsigned* st, bool is_t0) {
    XcdBarrier b; b.bar = bar; b.x = xb_xcc_id(); b.st = st;
    if (is_t0) (void)xb_add(&bar[XB_XCNT(b.x)], 1u);
    return b;
}
__device__ __forceinline__ void xcd_barrier_complete(unsigned* bar, unsigned x, unsigned& nloc, unsigned& nx) {
    const unsigned G = gridDim.x * gridDim.y * gridDim.z;
    unsigned sum, cnt, mine, sp = 0u;
    for (;;) {
        sum = 0u; cnt = 0u; mine = 0u;
#pragma unroll
        for (unsigned j = 0; j < 16; ++j) { const unsigned c = xb_ld(&bar[XB_XCNT(j)]); sum += c; cnt += (c > 0u) ? 1u : 0u; mine = (j == x) ? c : mine; }
        if (sum == G) break;
        __builtin_amdgcn_s_sleep(1);
        if ((++sp & 255u) == 0u) { if (xb_ld(&bar[XB_TMO])) break; if (sp > XB_SPIN_CAP) { atomicAdd(&bar[XB_TMO], 1u); break; } }
    }
    nloc = mine > 0u ? mine : 1u; nx = cnt > 0u ? cnt : 1u;
}

__device__ __forceinline__ void xcd_barrier(const XcdBarrier& b, bool is_t0) {
    asm volatile("s_waitcnt vmcnt(0)" ::: "memory");
    __syncthreads();
    if (is_t0) {
        unsigned* bar = b.bar;
        __builtin_amdgcn_s_waitcnt(0);
        unsigned nloc = b.st[0], nx = b.st[1];
        if (nloc == 0u) { xcd_barrier_complete(bar, b.x, nloc, nx); b.st[0] = nloc; b.st[1] = nx; }
        const unsigned old = xb_add(&bar[XB_XSUB(b.x)], 1u);
        const unsigned gen = old / nloc;
        if (old + 1u == (gen + 1u) * nloc) {
            __builtin_amdgcn_fence(__ATOMIC_RELEASE, "agent");
            asm volatile("s_waitcnt vmcnt(0)" ::: "memory");
            const unsigned og = xb_add(&bar[XB_TOP], 1u);
            const unsigned tg = og / nx;
            if (og + 1u == (tg + 1u) * nx) xb_add(&bar[XB_TOPGEN], 1u);
            else XB_SPIN(xb_ld(&bar[XB_TOPGEN]) == tg, bar);
            __builtin_amdgcn_fence(__ATOMIC_ACQUIRE, "agent");
            xb_add(&bar[XB_XGEN(b.x)], 1u);
            asm volatile("s_waitcnt vmcnt(0)" ::: "memory");
        } else {
            XB_SPIN(xb_ld(&bar[XB_XGEN(b.x)]) == gen, bar);
            __builtin_amdgcn_fence(__ATOMIC_ACQUIRE, "agent");
            asm volatile("s_waitcnt vmcnt(0)" ::: "memory");
        }
    }
    __syncthreads();
}

namespace pg8 {
constexpr int BM = 256, BK = 64, HALF = 128, HTB = HALF * BK * 2, STAGE_BYTES = 8 * HTB, NXCD = 8, WGM = 8;
__host__ __device__ __forceinline__ int lds_byte(int r, int c) { const int st = (r >> 4) * 2 + (c >> 5), rr = r & 15, cc = c & 31, ob = rr * 64 + cc * 2; return st * 1024 + (ob ^ (((ob >> 9) & 1) << 5)); }
__host__ __device__ __forceinline__ void stage_rc(int b, int& R, int& C) { const int st = b / 1024, sb = b % 1024, swz = sb ^ (((sb >> 9) & 1) << 5); R = (st >> 1) * 16 + swz / 64; C = (st & 1) * 32 + (swz % 64) / 2; }
__host__ __device__ __forceinline__ int perm32(int rho) { const int n = rho >> 4, i = rho & 15; return 8 * (i >> 2) + 4 * n + (i & 3); }

struct Unit { int pm, pn, idx; };
struct Gemm { const bf16_t* A; const bf16_t* Bt; };

struct StaticOrder {
    int nM, nN, nwg, G, c, wgm;
    __device__ void init(int M, int N, int G_, int c_, int wgm_ = WGM) { nM = M / BM; nN = N / BM; nwg = nM * nN; G = G_; c = c_; wgm = wgm_; }
    __device__ bool next(int i, Unit& u) const {
        const long L = (long)i * G + c; if (L >= nwg) return false;
        int wgid = (int)L; { const int q = nwg / NXCD, r = nwg % NXCD, xcd = wgid % NXCD, off = wgid / NXCD; wgid = (xcd < r ? xcd * (q + 1) : r * (q + 1) + (xcd - r) * q) + off; }
        const int nig = wgm * nN, gid = wgid / nig, fm = gid * wgm, gsz = (nM - fm) < wgm ? (nM - fm) : wgm;
        u.pm = fm + ((wgid % nig) % gsz); u.pn = (wgid % nig) / gsz; u.idx = i; return true;
    }
};

template <class Epi, int LDA, int LDB, int KK, int APN>
__device__ __forceinline__ void gemm_phase(LAS unsigned char* lds, const Gemm g, const StaticOrder& S, const Epi& E, int wv) {
    const int tid = tid_opaque(wv), wid = __builtin_amdgcn_readfirstlane(tid >> 6), lane = tid & 63, wr = wid >> 2, wc = wid & 3, fr = lane & 15, fq = lane >> 4;
    constexpr int nt = KK / BK;
    unsigned voffA[2], voffB[2];
#pragma unroll
    for (int i = 0; i < 2; ++i) { int R, C; stage_rc(tid * 16 + i * 8192, R, C); const int Rb = (R & ~31) + perm32(R & 31);
        voffA[i] = (unsigned)(R * LDA + C) * 2u; voffB[i] = (unsigned)(Rb * LDB + C) * 2u; }
    constexpr size_t kstep = (size_t)(BK * 2);
    constexpr size_t hstepA = (size_t)HALF * LDA * 2, hstepB = (size_t)HALF * LDB * 2;
    const unsigned ldsw = (unsigned)wid * 1024u;
    const int aoff = lds_byte(wr * 64 + fr, fq * 8), boff = lds_byte(wc * 32 + fr, fq * 8);
#define PG8_SA(b, h) (((b) * 2 + (h)) * HTB)
#define PG8_SB(b, h) ((4 + (b) * 2 + (h)) * HTB)
#define PG8_STAGE(bufoff, gbase, voff) do { _Pragma("unroll") for (int _i = 0; _i < 2; ++_i) \
        __builtin_amdgcn_global_load_lds((const unsigned*)((const char*)(gbase) + (voff)[_i]), (LAS unsigned*)(lds + (bufoff) + ldsw + _i * 8192), 16, 0, 0); } while (0)
#define PG8_LDA(dst, b, h) do { _Pragma("unroll") for (int m = 0; m < 4; ++m) _Pragma("unroll") for (int k = 0; k < 2; ++k) dst[m][k] = *(const LAS bf16x8*)(lds + PG8_SA(b, h) + aoff + m * 2048 + k * 1024); } while (0)
#define PG8_LDB(dst, b, h) do { _Pragma("unroll") for (int n = 0; n < 2; ++n) _Pragma("unroll") for (int k = 0; k < 2; ++k) dst[n][k] = *(const LAS bf16x8*)(lds + PG8_SB(b, h) + boff + n * 2048 + k * 1024); } while (0)
#define PG8_MMA(ai, bj, At, Bt) do { __builtin_amdgcn_s_setprio(1); _Pragma("unroll") for (int m = 0; m < 4; ++m) _Pragma("unroll") for (int n = 0; n < 2; ++n) _Pragma("unroll") for (int k = 0; k < 2; ++k) \
        acc[ai][bj][m][n] = __builtin_amdgcn_mfma_f32_16x16x32_bf16(Bt[n][k], At[m][k], acc[ai][bj][m][n], 0, 0, 0); __builtin_amdgcn_s_setprio(0); } while (0)
#define PG8_WAIT_V(n) asm volatile("s_waitcnt vmcnt(" #n ")" ::: "memory")
#define PG8_WAIT_L(n) asm volatile("s_waitcnt lgkmcnt(" #n ")" ::: "memory")
#define PG8_BAR __builtin_amdgcn_s_barrier()
#define PG8_SCHED __builtin_amdgcn_sched_barrier(0)
#define PG8_ABASE(u) ((const char*)g.A + ((size_t)(u).pm * BM * LDA + (size_t)(u).pn * APN) * 2)
#define PG8_BBASE(u) ((const char*)g.Bt + (size_t)(u).pn * BM * LDB * 2)
    Unit cur, nxt; int ui = 0;
    if (!S.next(0, cur)) return;
    float zf = 0.f; asm volatile("" : "+v"(zf));
    f32x4 acc[2][2][4][2];
#pragma unroll
    for (int a = 0; a < 2; ++a)
#pragma unroll
        for (int b = 0; b < 2; ++b)
#pragma unroll
            for (int m = 0; m < 4; ++m)
#pragma unroll
                for (int n = 0; n < 2; ++n) acc[a][b][m][n] = (f32x4){zf, zf, zf, zf};
    bf16x8 At[4][2], B0[2][2], B1[2][2];
    const char* cA = PG8_ABASE(cur); const char* cB = PG8_BBASE(cur);
    PG8_STAGE(PG8_SB(0, 0), cB, voffB); PG8_STAGE(PG8_SB(0, 1), cB + hstepB, voffB); PG8_STAGE(PG8_SA(0, 0), cA, voffA); PG8_STAGE(PG8_SA(0, 1), cA + hstepA, voffA);
    if (wr == 1) PG8_BAR;
    PG8_WAIT_V(2); PG8_BAR;
    PG8_STAGE(PG8_SB(1, 0), cB + kstep, voffB); PG8_STAGE(PG8_SA(1, 0), cA + kstep, voffA); PG8_STAGE(PG8_SB(1, 1), cB + hstepB + kstep, voffB);
    PG8_WAIT_V(6); PG8_BAR;
    for (;;) {
        const bool has_next = S.next(ui + 1, nxt);
        const char* nA = has_next ? PG8_ABASE(nxt) : cA; const char* nB = has_next ? PG8_BBASE(nxt) : cB;
#pragma nounroll
        for (int t = 0; t < nt; t += 2) {
            const bool last = (t == nt - 2);
            const char* a1 = cA + (size_t)(t + 1) * kstep;
            const char* a2 = last ? nA : cA + (size_t)(t + 2) * kstep; const char* b2 = last ? nB : cB + (size_t)(t + 2) * kstep;
            const char* a3 = a2 + kstep; const char* b3 = b2 + kstep;
            PG8_LDB(B0, 0, 0); PG8_LDB(B1, 0, 1); PG8_SCHED; PG8_LDA(At, 0, 0); PG8_STAGE(PG8_SA(1, 1), a1 + hstepA, voffA);
            PG8_WAIT_V(8); PG8_WAIT_L(0); PG8_BAR; PG8_MMA(0, 0, At, B0); PG8_MMA(0, 1, At, B1); PG8_BAR; PG8_SCHED;
            PG8_LDA(At, 0, 1); PG8_STAGE(PG8_SB(0, 0), b2, voffB); PG8_STAGE(PG8_SB(0, 1), b2 + hstepB, voffB); PG8_STAGE(PG8_SA(0, 0), a2, voffA);
            PG8_WAIT_V(8); PG8_WAIT_L(0); PG8_BAR; PG8_MMA(1, 0, At, B0); PG8_MMA(1, 1, At, B1); PG8_BAR; PG8_SCHED;
            PG8_LDB(B0, 1, 0); PG8_LDB(B1, 1, 1); PG8_SCHED; PG8_LDA(At, 1, 0); PG8_STAGE(PG8_SA(0, 1), a2 + hstepA, voffA);
            PG8_WAIT_V(8); PG8_WAIT_L(0); PG8_BAR; PG8_MMA(0, 0, At, B0); PG8_MMA(0, 1, At, B1); PG8_BAR; PG8_SCHED;
            PG8_LDA(At, 1, 1); PG8_STAGE(PG8_SB(1, 0), b3, voffB); PG8_STAGE(PG8_SB(1, 1), b3 + hstepB, voffB); PG8_STAGE(PG8_SA(1, 0), a3, voffA);
            PG8_WAIT_V(8); PG8_WAIT_L(0); PG8_BAR; PG8_MMA(1, 0, At, B0); PG8_MMA(1, 1, At, B1); PG8_BAR; PG8_SCHED;
        }
        if (wr == 0) PG8_BAR;
        E(acc, cur, wr, wc, fr, fq);
        if (!has_next) break;
#pragma unroll
        for (int a = 0; a < 2; ++a)
#pragma unroll
            for (int b = 0; b < 2; ++b)
#pragma unroll
                for (int m = 0; m < 4; ++m)
#pragma unroll
                    for (int n = 0; n < 2; ++n) acc[a][b][m][n] = (f32x4){zf, zf, zf, zf};
        cur = nxt; cA = nA; cB = nB; ++ui;
        if (wr == 1) PG8_BAR;
    }
    PG8_WAIT_V(0);
    PG8_BAR;
#undef PG8_SA
#undef PG8_SB
#undef PG8_STAGE
#undef PG8_LDA
#undef PG8_LDB
#undef PG8_MMA
#undef PG8_WAIT_V
#undef PG8_WAIT_L
#undef PG8_BAR
#undef PG8_SCHED
#undef PG8_ABASE
#undef PG8_BBASE
}
}
using pg8::Unit;

typedef const f32x4 (&AccRef)[2][2][4][2];

struct EpiInProj {
    const LAS float* rsl;
    unsigned char* ws; const float* dt_bias;
    __device__ __forceinline__ void operator()(AccRef acc, const Unit& u, int wr, int wc, int fr, int fq) const {
        run(acc, u, wr, wc, fr, fq);
    }
    __device__ __forceinline__ void run(AccRef acc, const Unit& u, int wr, int wc, int fr, int fq) const {
        const int pn = u.pn, row0 = u.pm * 256 + wr * 64 + fr;
        bf16_t* const zs = (bf16_t*)(ws + WS_ZS); bf16_t* const xbc = (bf16_t*)(ws + WS_XBC); bf16_t* const pu = (bf16_t*)(ws + WS_PU); bf16_t* const pg = (bf16_t*)(ws + WS_PG);
        bf16_t* const qkv = (bf16_t*)(ws + WS_QKV); bf16_t* const sg = (bf16_t*)(ws + WS_SG); bf16_t* const mg = (bf16_t*)(ws + WS_MG); float* const dt = (float*)(ws + WS_DT);
        float rs[2][4];
#pragma unroll
        for (int ai = 0; ai < 2; ++ai)
#pragma unroll
            for (int m = 0; m < 4; ++m) rs[ai][m] = rsl[u.idx * 256 + ai * 128 + wr * 64 + m * 16 + fr];
        if (pn == 18) {
            if (wc == 0) {
                const f32x4 bvn[2] = {*(const f32x4*)(dt_bias + 8 * fq), *(const f32x4*)(dt_bias + 8 * fq + 4)};
#pragma unroll
                for (int ai = 0; ai < 2; ++ai)
#pragma unroll
                    for (int m = 0; m < 4; ++m) { const int row = row0 + ai * 128 + m * 16;
#pragma unroll
                        for (int n = 0; n < 2; ++n) { const f32x4 bv = bvn[n]; f32x4 v = acc[ai][0][m][n] * rs[ai][m] + bv; f32x4 o;
#pragma unroll
                            for (int j = 0; j < 4; ++j) o[j] = fmaxf(v[j], 0.f) + log1pf(__expf(-fabsf(v[j])));
                            *(f32x4*)(dt + (size_t)row * 32 + 8 * fq + 4 * n) = o; } }
            }
            return;
        }
        bf16_t* base; int ld, ct, type; float sc = 1.f;
        if (pn < 8)       { base = zs;  ld = 2048; ct = pn;      type = 0; }
        else if (pn < 18) { base = xbc; ld = 2560; ct = pn - 8;  type = 0; }
        else if (pn < 23) { base = pu;  ld = 1024; ct = pn - 19; type = 0; }
        else if (pn < 27) { base = pg;  ld = 1024; ct = pn - 23; type = 1; }
        else if (pn < 39) { base = qkv; ld = 3072; ct = pn - 27; type = 0; sc = (pn < 31) ? 0.125f * 1.4426950408889634f : 1.f; }
        else if (pn < 43) { base = sg;  ld = 1024; ct = pn - 39; type = 0; }
        else              { base = mg;  ld = 3072; ct = pn - 43; type = 2; }
#pragma unroll
        for (int ai = 0; ai < 2; ++ai)
#pragma unroll
            for (int m = 0; m < 4; ++m) { bf16_t* rowp = base + (size_t)(row0 + ai * 128 + m * 16) * ld + ct * 256 + wc * 32 + 8 * fq; const float r = rs[ai][m] * sc;
#pragma unroll
                for (int bj = 0; bj < 2; ++bj) { f32x4 v0 = acc[ai][bj][m][0] * r, v1 = acc[ai][bj][m][1] * r;
                    if (type == 1) {
#pragma unroll
                        for (int j = 0; j < 4; ++j) { v0[j] = siluf_(v0[j]); v1[j] = siluf_(v1[j]); } }
                    else if (type == 2) {
#pragma unroll
                        for (int j = 0; j < 4; ++j) { v0[j] = sigmoidf_(v0[j]); v1[j] = sigmoidf_(v1[j]); } }
                    u32x4 w; w.x = pk2(v0[0], v0[1]); w.y = pk2(v0[2], v0[3]); w.z = pk2(v1[0], v1[1]); w.w = pk2(v1[2], v1[3]);
                    *(u32x4*)(rowp + bj * 128) = w; } }
    }
};

__device__ __forceinline__ void p1_rstd(const float* xss, const pg8::StaticOrder& S, LAS float* rsl, int wv) {
    const int tid = tid_opaque(wv), row = tid >> 1, hf2 = tid & 1, lane = tid & 63;
#pragma unroll 1
    for (int i0 = 0; i0 < 16; i0 += 8) {
        f32x4 v[8][2]; bool ok[8];
#pragma unroll
        for (int j = 0; j < 8; ++j) { Unit u; ok[j] = S.next(i0 + j, u); const int pm = ok[j] ? u.pm : 0; const f32x4* p = (const f32x4*)(xss + (size_t)(pm * 256 + row) * 16 + hf2 * 8); v[j][0] = p[0]; v[j][1] = p[1]; }
#pragma unroll
        for (int j = 0; j < 8; ++j) { float sm = ((v[j][0].x + v[j][0].y) + (v[j][0].z + v[j][0].w)) + ((v[j][1].x + v[j][1].y) + (v[j][1].z + v[j][1].w)); sm += shx(sm, 1, lane);
            if (ok[j] && hf2 == 0 && i0 + j < 15) rsl[(i0 + j) * 256 + row] = __builtin_amdgcn_rsqf(sm * (1.f / DM) + EPS); }
    }
    __syncthreads();
}


struct EpiPool {
    unsigned char* ws; const float* pscale;
    __device__ __forceinline__ int nstores(const Unit&) const { return 0; }
    __device__ __forceinline__ void operator()(AccRef acc, const Unit& u, int wr, int wc, int fr, int fq) const {
        bf16_t* const out = (bf16_t*)(ws + WS_PU); const bf16_t* const pg = (const bf16_t*)(ws + WS_PG);
        const int row0 = u.pm * 256 + wr * 64 + fr, col0 = u.pn * 256 + wc * 32 + 8 * fq;
        u32x4 gw[2][2][4]; f32x4 s0[2], s1[2];
#pragma unroll
        for (int bj = 0; bj < 2; ++bj) { s0[bj] = *(const f32x4*)(pscale + col0 + bj * 128); s1[bj] = *(const f32x4*)(pscale + col0 + bj * 128 + 4);
#pragma unroll
            for (int ai = 0; ai < 2; ++ai)
#pragma unroll
                for (int m = 0; m < 4; ++m) gw[bj][ai][m] = *(const u32x4*)(pg + (size_t)(row0 + ai * 128 + m * 16) * 1024 + col0 + bj * 128); }
        __builtin_amdgcn_sched_barrier(0);
#pragma unroll
        for (int bj = 0; bj < 2; ++bj)
#pragma unroll
            for (int ai = 0; ai < 2; ++ai)
#pragma unroll
                for (int m = 0; m < 4; ++m) { const size_t off = (size_t)(row0 + ai * 128 + m * 16) * 1024 + col0 + bj * 128; float gf[8]; unpack8(gw[bj][ai][m], gf);
                    const f32x4 v0 = acc[ai][bj][m][0] * s0[bj], v1 = acc[ai][bj][m][1] * s1[bj];
                    u32x4 w; w.x = pk2(v0[0] * gf[0], v0[1] * gf[1]); w.y = pk2(v0[2] * gf[2], v0[3] * gf[3]); w.z = pk2(v1[0] * gf[4], v1[1] * gf[5]); w.w = pk2(v1[2] * gf[6], v1[3] * gf[7]);
                    *(u32x4*)(out + off) = w; }
    }
};

template <int STEP> struct EpiMerge {
    unsigned char* ws; const LAS float* rsl;
    __device__ __forceinline__ int nstores(const Unit&) const { return 0; }
    __device__ __forceinline__ void operator()(AccRef acc, const Unit& u, int wr, int wc, int fr, int fq) const {
        const bf16_t* const mg = (const bf16_t*)(ws + WS_MG); bf16_t* const mb = (bf16_t*)(ws + WS_MB);
        const int row0 = u.pm * 256 + wr * 64 + fr, col0 = u.pn * 256 + wc * 32 + 8 * fq;
#pragma unroll
        for (int ai = 0; ai < 2; ++ai) {
            u32x4 gw[4][2], mw[4][2]; float r[4];
#pragma unroll
            for (int m = 0; m < 4; ++m) { const int row = row0 + ai * 128 + m * 16; r[m] = (STEP == 0) ? rsl[u.idx * 256 + ai * 128 + wr * 64 + m * 16 + fr] : 1.f;
#pragma unroll
                for (int bj = 0; bj < 2; ++bj) { gw[m][bj] = *(const u32x4*)(mg + (size_t)row * 3072 + STEP * 1024 + col0 + bj * 128);
                    if (STEP != 0) mw[m][bj] = *(const u32x4*)(mb + (size_t)row * 1024 + col0 + bj * 128); } }
            __builtin_amdgcn_sched_barrier(0);
#pragma unroll
            for (int m = 0; m < 4; ++m)
#pragma unroll
                for (int bj = 0; bj < 2; ++bj) { float gf[8]; unpack8(gw[m][bj], gf);
                    f32x4 v0 = acc[ai][bj][m][0] * r[m], v1 = acc[ai][bj][m][1] * r[m];
                    v0[0] *= gf[0]; v0[1] *= gf[1]; v0[2] *= gf[2]; v0[3] *= gf[3]; v1[0] *= gf[4]; v1[1] *= gf[5]; v1[2] *= gf[6]; v1[3] *= gf[7];
                    if (STEP != 0) { float pf[8]; unpack8(mw[m][bj], pf); v0[0] += pf[0]; v0[1] += pf[1]; v0[2] += pf[2]; v0[3] += pf[3]; v1[0] += pf[4]; v1[1] += pf[5]; v1[2] += pf[6]; v1[3] += pf[7]; }
                    u32x4 w; w.x = pk2(v0[0], v0[1]); w.y = pk2(v0[2], v0[3]); w.z = pk2(v1[0], v1[1]); w.w = pk2(v1[2], v1[3]);
                    *(u32x4*)(mb + (size_t)(row0 + ai * 128 + m * 16) * 1024 + col0 + bj * 128) = w; }
            __builtin_amdgcn_sched_barrier(0);
        }
    }
};
__device__ __forceinline__ void p3_rstd(const float* ssq, const pg8::StaticOrder& S, LAS float* rsl, int wv) {
    const int tid = tid_opaque(wv), row = tid >> 1, hf2 = tid & 1, lane = tid & 63;
#pragma unroll 1
    for (int i = 0; i < 15; ++i) { Unit u; if (!S.next(i, u)) break;
        const f32x4* p = (const f32x4*)(ssq + (size_t)(u.pm * 256 + row) * 32 + hf2 * 16); const f32x4 a = p[0], b = p[1], c = p[2], d = p[3];
        float sm = (((a.x + a.y) + (a.z + a.w)) + ((b.x + b.y) + (b.z + b.w))) + (((c.x + c.y) + (c.z + c.w)) + ((d.x + d.y) + (d.z + d.w))); sm += shx(sm, 1, lane);
        if (hf2 == 0) rsl[i * 256 + row] = __builtin_amdgcn_rsqf(sm * (1.f / SSM_W) + EPS); }
    __syncthreads();
}

template <bool DRY> struct EpiOutT {
    const float* xin; float* x; bf16_t* xb; float* xss;
    __device__ __forceinline__ int nstores(const Unit&) const { return 0; }
    __device__ __forceinline__ void operator()(AccRef acc, const Unit& u, int wr, int wc, int fr, int fq) const {
        const int row0 = u.pm * 256 + wr * 64 + fr, col0 = u.pn * 256 + wc * 32 + 8 * fq;
#pragma unroll
        for (int ai = 0; ai < 2; ++ai) {
            f32x4 xv[4][2][2];
#pragma unroll
            for (int m = 0; m < 4; ++m)
#pragma unroll
                for (int bj = 0; bj < 2; ++bj) { const size_t off = (size_t)(row0 + ai * 128 + m * 16) * 1024 + col0 + bj * 128; xv[m][bj][0] = *(const f32x4*)(xin + off); xv[m][bj][1] = *(const f32x4*)(xin + off + 4); }
            __builtin_amdgcn_sched_barrier(0);
#pragma unroll
            for (int m = 0; m < 4; ++m) { const int row = row0 + ai * 128 + m * 16; float ss = 0.f;
#pragma unroll
                for (int bj = 0; bj < 2; ++bj) { const size_t off = (size_t)row * 1024 + col0 + bj * 128;
                    const f32x4 v0 = acc[ai][bj][m][0] + xv[m][bj][0], v1 = acc[ai][bj][m][1] + xv[m][bj][1];
                    if (!DRY) { *(f32x4*)(x + off) = v0; *(f32x4*)(x + off + 4) = v1; }
                    ss += (v0[0] * v0[0] + v0[1] * v0[1]) + (v0[2] * v0[2] + v0[3] * v0[3]) + (v1[0] * v1[0] + v1[1] * v1[1]) + (v1[2] * v1[2] + v1[3] * v1[3]);
                    u32x4 w; w.x = pk2(v0[0], v0[1]); w.y = pk2(v0[2], v0[3]); w.z = pk2(v1[0], v1[1]); w.w = pk2(v1[2], v1[3]); if (!DRY) *(u32x4*)(xb + off) = w; }
                { const int ln = fr + 16 * fq; ss += shx(ss, 16, ln); ss += shx(ss, 32, ln); }
                if (!DRY && fq == 0) xss[(size_t)row * 16 + u.pn * 4 + wc] = ss; }
            __builtin_amdgcn_sched_barrier(0);
        }
    }
};

struct EpiMulti {
    int mode; EpiInProj ip; EpiMerge<1> m1; EpiMerge<2> m2; EpiOutT<false> eo;
    __device__ __forceinline__ void operator()(AccRef acc, const Unit& u, int wr, int wc, int fr, int fq) const {
        if (mode == 0) ip(acc, u, wr, wc, fr, fq); else if (mode == 1) m1(acc, u, wr, wc, fr, fq); else if (mode == 2) m2(acc, u, wr, wc, fr, fq); else eo(acc, u, wr, wc, fr, fq);
    }
};

struct Args {
    const float *x, *norm_w, *w_in, *conv_w, *conv_b, *dt_bias, *a_log, *d_skip, *ssm_norm_w, *pool_w, *pool_scale, *w_proj_ssm, *w_proj_pool, *w_proj_sb, *w_out, *final_norm_w;
    float* out; unsigned char* ws; int ph_lo, ph_hi;
};

__device__ __forceinline__ void transpose_item(const float* W, int K, int N, bf16_t* WT, int dst_row0, const float* kscale, LAS float* scr, int kb, int nb, int lane) {
    const int k0 = 64 * kb, n0 = 32 * nb;
    f32x4 wv_[8];
#pragma unroll
    for (int j = 0; j < 8; ++j) wv_[j] = *(const f32x4*)(W + (size_t)(k0 + 8 * j + (lane >> 3)) * N + n0 + 4 * (lane & 7));
    const int c = lane & 7;
    f32x4 ks0 = (f32x4){1.f, 1.f, 1.f, 1.f}, ks1 = ks0;
    if (kscale) { ks0 = *(const f32x4*)(kscale + k0 + 8 * c); ks1 = *(const f32x4*)(kscale + k0 + 8 * c + 4); }
#pragma unroll
    for (int j = 0; j < 8; ++j) { LAS float* d = scr + (8 * j + (lane >> 3)) * 33 + 4 * (lane & 7); d[0] = wv_[j].x; d[1] = wv_[j].y; d[2] = wv_[j].z; d[3] = wv_[j].w; }
    asm volatile("s_waitcnt lgkmcnt(0)" ::: "memory");
#pragma unroll
    for (int j = 0; j < 4; ++j) { const int n = (lane >> 3) + 8 * j; const LAS float* s = scr + (8 * c) * 33 + n;
        u32x4 o; o.x = pk2(s[0 * 33] * ks0.x, s[1 * 33] * ks0.y); o.y = pk2(s[2 * 33] * ks0.z, s[3 * 33] * ks0.w); o.z = pk2(s[4 * 33] * ks1.x, s[5 * 33] * ks1.y); o.w = pk2(s[6 * 33] * ks1.z, s[7 * 33] * ks1.w);
        *(u32x4*)(WT + (size_t)(dst_row0 + n0 + n) * K + k0 + 8 * c) = o; }
    asm volatile("s_waitcnt lgkmcnt(0)" ::: "memory");
}

__device__ __forceinline__ void p0_prologue(const Args& a, LAS unsigned char* lds, int wv) {
    const int tid = tid_opaque(wv), lane = tid & 63, wave = tid >> 6;
    const int gw = blockIdx.x * 8 + wave, NGW = gridDim.x * 8;
    LAS float* scr = (LAS float*)(lds + wave * 8704);
    constexpr int I_IN = 16 * 433, I_SSM = 32 * 32, I_SQ = 16 * 32, I_PW = 4 * 4 * 8, I_LAYER = I_IN + I_SSM + 3 * I_SQ + I_PW;
    for (int it = gw; it < DEPTH * I_LAYER; it += NGW) {
        const int l = it / I_LAYER; int r = it % I_LAYER;
        if (r < I_IN) { const int kb = r / 433, nb = r % 433; const int n0 = nb * 32;
            transpose_item(a.w_in + (size_t)l * 1024 * IN_COLS, 1024, IN_COLS, (bf16_t*)(a.ws + WS_WIN) + (size_t)l * NPAD * 1024, (n0 >= 4640) ? 224 : 0, a.norm_w + l * 1024, scr, kb, nb, lane); continue; }
        r -= I_IN;
        if (r < I_SSM) { transpose_item(a.w_proj_ssm + (size_t)l * 2048 * 1024, 2048, 1024, (bf16_t*)(a.ws + WS_WSSM) + (size_t)l * 1024 * 2048, 0, a.ssm_norm_w + l * 2048, scr, r / 32, r % 32, lane); continue; }
        r -= I_SSM;
        if (r < I_SQ) { transpose_item(a.w_proj_pool + (size_t)l * 1024 * 1024, 1024, 1024, (bf16_t*)(a.ws + WS_WPOOL) + (size_t)l * 1024 * 1024, 0, nullptr, scr, r / 32, r % 32, lane); continue; }
        r -= I_SQ;
        if (r < I_SQ) { transpose_item(a.w_proj_sb + (size_t)l * 1024 * 1024, 1024, 1024, (bf16_t*)(a.ws + WS_WSB) + (size_t)l * 1024 * 1024, 0, nullptr, scr, r / 32, r % 32, lane); continue; }
        r -= I_SQ;
        if (r < I_SQ) { transpose_item(a.w_out + (size_t)l * 1024 * 1024, 1024, 1024, (bf16_t*)(a.ws + WS_WOUT) + (size_t)l * 1024 * 1024, 0, nullptr, scr, r / 32, r % 32, lane); continue; }
        r -= I_SQ;
        { const int g = r / 32, rr = r % 32;
          transpose_item(a.pool_w + ((size_t)l * 4 + g) * 256 * 256, 256, 256, (bf16_t*)(a.ws + WS_PW) + (size_t)l * 1024 * 256, g * 256, nullptr, scr, rr / 8, rr % 8, lane); }
    }
    { const int gt = blockIdx.x * 512 + tid, NGT = gridDim.x * 512; constexpr int PER_L = 224 * 1024 / 8; unsigned zu = 0u; asm volatile("" : "+v"(zu));
      for (int i = gt; i < DEPTH * PER_L; i += NGT) { const int l = i / PER_L, r = i % PER_L;
          *(u32x4*)((bf16_t*)(a.ws + WS_WIN) + (size_t)l * NPAD * 1024 + (size_t)4640 * 1024 + (size_t)r * 8) = (u32x4){zu, zu, zu, zu}; } }
    for (int m0 = gw; m0 < M_ALL; m0 += 4 * NGW) {
        f32x4 v[4][4];
#pragma unroll
        for (int q = 0; q < 4; ++q)
#pragma unroll
            for (int j = 0; j < 4; ++j) v[q][j] = ((const f32x4*)(a.x + (size_t)(m0 + q * NGW) * DM) + lane)[64 * j];
#pragma unroll
        for (int q = 0; q < 4; ++q) { const int m = m0 + q * NGW; u32x2* brow = (u32x2*)((bf16_t*)(a.ws + WS_XB) + (size_t)m * DM) + lane;
            float s = 0.f;
#pragma unroll
            for (int j = 0; j < 4; ++j) { const f32x4 t = v[q][j]; s += (t.x * t.x + t.y * t.y) + (t.z * t.z + t.w * t.w); u32x2 w; w.x = pk2(t.x, t.y); w.y = pk2(t.z, t.w); brow[64 * j] = w; }
            s = wave_sum(s, lane);
            if (lane < 16) ((float*)(a.ws + WS_XSS))[(size_t)m * 16 + lane] = (lane == 0) ? s : 0.f; }
    }
}

template <int WIN> __device__ __forceinline__ void pool_item(const bf16_t* pu, bf16_t* mixed, int t0, int c0, unsigned zu) {
    constexpr int NP = WIN - 1;
    const bool first = (t0 & (SEQ - 1)) == 0;
    u32x4 raw[NP + 16];
#pragma unroll
    for (int k = 0; k < NP; ++k) raw[k] = first ? (u32x4){zu, zu, zu, zu} : *(const u32x4*)((const char*)pu + (unsigned)(((t0 - NP + k) * 1024 + c0) * 2));
#pragma unroll
    for (int i = 0; i < 16; ++i) raw[NP + i] = *(const u32x4*)((const char*)pu + (unsigned)(((t0 + i) * 1024 + c0) * 2));
    float s[8];
#pragma unroll
    for (int j = 0; j < 8; ++j) s[j] = 0.f;
#pragma unroll
    for (int k = 0; k < NP; ++k) { float v[8]; unpack8(raw[k], v);
#pragma unroll
        for (int j = 0; j < 8; ++j) s[j] += v[j]; }
#pragma unroll
    for (int i = 0; i < 16; ++i) { float cur[8], old[8], o[8]; unpack8(raw[NP + i], cur); unpack8(raw[i], old);
        const int cnt = first ? ((i + 1 < WIN) ? i + 1 : WIN) : WIN; const float inv = 1.f / (float)cnt;
#pragma unroll
        for (int j = 0; j < 8; ++j) { s[j] += cur[j]; o[j] = s[j] * inv - cur[j]; s[j] -= old[j]; }
        *(u32x4*)((char*)mixed + (unsigned)(((t0 + i) * 1024 + c0) * 2)) = pack8(o); }
}
__device__ __forceinline__ void p2a_elementwise(const Args& a, int l, int wv) {
    const int gt = blockIdx.x * 512 + tid_opaque(wv), NGT = gridDim.x * 512;
    unsigned zu = 0u; asm volatile("" : "+v"(zu));
    const bf16_t* xbc = (const bf16_t*)(a.ws + WS_XBC); bf16_t* xbcc = (bf16_t*)(a.ws + WS_XBCC);
    const float* cw = a.conv_w + (size_t)l * 4 * CONV_CH; const float* cb = a.conv_b + (size_t)l * CONV_CH;
    for (int it = gt; it < (MH / 16) * 64; it += NGT) {
        const int cgp = it & 63, tc = it >> 6, t0 = tc * 16, c0 = 2048 + cgp * 8;
        const bool first = (t0 & (SEQ - 1)) == 0;
        u32x4 raw[19];
#pragma unroll
        for (int k = 0; k < 3; ++k) raw[k] = first ? (u32x4){zu, zu, zu, zu} : *(const u32x4*)((const char*)xbc + (unsigned)(((t0 - 3 + k) * CONV_CH + c0) * 2));
#pragma unroll
        for (int i = 0; i < 16; ++i) raw[3 + i] = *(const u32x4*)((const char*)xbc + (unsigned)(((t0 + i) * CONV_CH + c0) * 2));
        float w0[8], w1[8], w2[8], w3[8], bb[8];
#pragma unroll
        for (int j = 0; j < 8; j += 4) { const f32x4 q0 = *(const f32x4*)(cw + 0 * CONV_CH + c0 + j), q1 = *(const f32x4*)(cw + 1 * CONV_CH + c0 + j), q2 = *(const f32x4*)(cw + 2 * CONV_CH + c0 + j), q3 = *(const f32x4*)(cw + 3 * CONV_CH + c0 + j), qb = *(const f32x4*)(cb + c0 + j);
#pragma unroll
            for (int e = 0; e < 4; ++e) { w0[j + e] = q0[e]; w1[j + e] = q1[e]; w2[j + e] = q2[e]; w3[j + e] = q3[e]; bb[j + e] = qb[e]; } }
        float u3[8], u2[8], u1[8];
        unpack8(raw[0], u3); unpack8(raw[1], u2); unpack8(raw[2], u1);
#pragma unroll
        for (int i = 0; i < 16; ++i) {
            float u0[8], o[8]; unpack8(raw[3 + i], u0);
#pragma unroll
            for (int j = 0; j < 8; ++j) { const float v = bb[j] + w0[j] * u3[j] + w1[j] * u2[j] + w2[j] * u1[j] + w3[j] * u0[j]; o[j] = siluf_(v); u3[j] = u2[j]; u2[j] = u1[j]; u1[j] = u0[j]; }
            *(u32x4*)((char*)xbcc + (unsigned)(((t0 + i) * CONV_CH + c0) * 2)) = pack8(o);
        }
    }
    const bf16_t* pu = (const bf16_t*)(a.ws + WS_PU); bf16_t* mixed = (bf16_t*)(a.ws + WS_MIXED);
    for (int it = gt; it < (MH / 16) * 128; it += NGT) {
        const int j64 = it & 63, grp = (it >> 6) & 3, tc2 = it >> 8;
        const int t0 = (tc2 * 2 + (j64 >> 5)) * 16, c0 = (grp * 32 + (j64 & 31)) * 8;
        if (grp == 0) pool_item<2>(pu, mixed, t0, c0, zu); else if (grp == 1) pool_item<4>(pu, mixed, t0, c0, zu); else if (grp == 2) pool_item<8>(pu, mixed, t0, c0, zu); else pool_item<16>(pu, mixed, t0, c0, zu);
    }
}

constexpr int SD_P = 272, SD_XP = 144;
constexpr int SD_XN = 0, SD_XW = SD_XN + 128 * SD_XP, SD_BN = SD_XW + 128 * SD_XP, SD_CN = SD_BN + 128 * SD_P, SD_SI = SD_CN + 128 * SD_P;
constexpr int SD_AC = SD_SI + 64 * SD_P, SD_DT = SD_AC + 8192, SD_SS = SD_DT + 8192, SD_CW = SD_SS + 2048, SD_END = SD_CW + 1280;
static_assert(SD_END <= LDS_BYTES - 16, "SSD LDS images");
__device__ __forceinline__ void tr_read4(u32x2& a, u32x2& b, u32x2& c, u32x2& d, unsigned a0, unsigned a1, unsigned a2, unsigned a3) {
    asm volatile("ds_read_b64_tr_b16 %0, %4\n\tds_read_b64_tr_b16 %1, %5\n\tds_read_b64_tr_b16 %2, %6\n\tds_read_b64_tr_b16 %3, %7\n\ts_waitcnt lgkmcnt(0)"
                 : "=&v"(a), "=&v"(b), "=&v"(c), "=&v"(d) : "v"(a0), "v"(a1), "v"(a2), "v"(a3) : "memory");
}
__device__ __forceinline__ void tr_read8(u32x2& a, u32x2& b, u32x2& c, u32x2& d, u32x2& e, u32x2& f, u32x2& g, u32x2& h, unsigned a0, unsigned a1, unsigned a2, unsigned a3, unsigned a4, unsigned a5, unsigned a6, unsigned a7) {
    asm volatile("ds_read_b64_tr_b16 %0, %8\n\tds_read_b64_tr_b16 %1, %9\n\tds_read_b64_tr_b16 %2, %10\n\tds_read_b64_tr_b16 %3, %11\n\tds_read_b64_tr_b16 %4, %12\n\tds_read_b64_tr_b16 %5, %13\n\tds_read_b64_tr_b16 %6, %14\n\tds_read_b64_tr_b16 %7, %15\n\ts_waitcnt lgkmcnt(0)"
                 : "=&v"(a), "=&v"(b), "=&v"(c), "=&v"(d), "=&v"(e), "=&v"(f), "=&v"(g), "=&v"(h) : "v"(a0), "v"(a1), "v"(a2), "v"(a3), "v"(a4), "v"(a5), "v"(a6), "v"(a7) : "memory");
}
template <bool DRY>
__device__ __forceinline__ void ssd_item(const Args& a, int l, int bl, int h, LAS unsigned char* lds, int wv) {
    const int tid = tid_opaque(wv), lane = tid & 63, wave = tid >> 6, r = lane & 31, hh = lane >> 5, pb = wave >> 2, lb = (wave & 3) ^ (pb ? 3 : 0);
    const bf16_t* xbcc = (const bf16_t*)(a.ws + WS_XBCC); const bf16_t* xbc = (const bf16_t*)(a.ws + WS_XBC); bf16_t* zs = (bf16_t*)(a.ws + WS_ZS); const float* dt = (const float*)(a.ws + WS_DT); float* ssq = (float*)(a.ws + WS_SSQ);
    const float A = -__expf(a.a_log[l * NHEAD + h]), Dh = a.d_skip[l * NHEAD + h]; const int g = h >> 4; const size_t rowbase = (size_t)bl * SEQ;
    LAS float* acum_all = (LAS float*)(lds + SD_AC); LAS float* dts_all = (LAS float*)(lds + SD_DT); LAS float* ssum = (LAS float*)(lds + SD_SS);
    const unsigned lds0 = (unsigned)(size_t)lds;
    const int trq = (lane & 15) >> 2, trp = lane & 3, trblk = (lane >> 4) & 1;
    const unsigned trx = lds0 + (unsigned)(trq * SD_XP + (32 * pb + 16 * trblk + 4 * trp) * 2);
    const unsigned trb = lds0 + (unsigned)(SD_BN + trq * SD_P + (32 * lb + 16 * trblk + 4 * trp) * 2);
    float zf = 0.f; asm volatile("" : "+v"(zf));
    __syncthreads();
    for (int i = tid; i < 64 * SD_P / 4; i += 512) ((LAS unsigned*)(lds + SD_SI))[i] = 0u;
    if (tid < 320) { const int k = tid >> 6, cc = tid & 63; ((LAS float*)(lds + SD_CW))[tid] = (k < 4) ? a.conv_w[((size_t)l * 4 + k) * CONV_CH + h * 64 + cc] : a.conv_b[(size_t)l * CONV_CH + h * 64 + cc]; }
    const unsigned xoff = (unsigned)(((tid >> 3) * CONV_CH + h * 64 + (tid & 7) * 8) * 2), boff = (unsigned)(((tid >> 4) * CONV_CH + 2048 + g * 128 + (tid & 15) * 8) * 2);
#define SSD_LOAD_X(rr0, FIRST) do { \
        _Pragma("unroll") for (int j = 0; j < 2; ++j) { const int tl = (tid >> 3) + 64 * j; \
            _Pragma("unroll") for (int k = 0; k < 4; ++k) { const char* rb_ = (const char*)(xbc + ((rr0) + 64 * j + k - 3) * CONV_CH); \
                xr[j][k] = ((FIRST) && tl + k < 3) ? (u32x4){zu, zu, zu, zu} : *(const u32x4*)(rb_ + xoff); } } \
        } while (0)
#define SSD_LOAD_BC(rr0) do { \
        _Pragma("unroll") for (int j = 0; j < 4; ++j) { const char* rb_ = (const char*)(xbcc + ((rr0) + 32 * j) * CONV_CH); br[j] = *(const u32x4*)(rb_ + boff); cr[j] = *(const u32x4*)(rb_ + boff + 512); } \
        } while (0)
    unsigned zu = 0u; asm volatile("" : "+v"(zu));
    u32x4 xr[2][4], br[4], cr[4];
    SSD_LOAD_X(rowbase, true); SSD_LOAD_BC(rowbase);
    { float dv[4];
#pragma unroll
      for (int q = 0; q < 4; ++q) dv[q] = dt[(rowbase + (size_t)(wave * 256 + q * 64 + lane)) * 32 + h];
#pragma unroll
      for (int q = 0; q < 4; ++q) { float sv = dv[q] * A;
#pragma unroll
          for (int o = 1; o < 64; o <<= 1) { const float t = __int_as_float(__builtin_amdgcn_ds_bpermute(((lane - o) & 63) << 2, __float_as_int(sv))); sv += (lane >= o) ? t : 0.f; }
          acum_all[wave * 256 + q * 64 + lane] = sv; dts_all[wave * 256 + q * 64 + lane] = dv[q]; }
      asm volatile("s_waitcnt lgkmcnt(0)" ::: "memory");
#pragma unroll
      for (int q = 1; q < 4; q += 2) { const float tot = acum_all[wave * 256 + (q - 1) * 64 + 63]; acum_all[wave * 256 + q * 64 + lane] += tot; } }
    f32x16 sacc;
#pragma unroll
    for (int i = 0; i < 16; ++i) sacc[i] = zf;
#pragma unroll 1
    for (int c = 0; c < SEQ / 128; ++c) {
        const size_t r0 = rowbase + (size_t)c * 128;
        const LAS float* acum = acum_all + c * 128; const LAS float* dts = dts_all + c * 128;
        __syncthreads();
        const float a_end = acum[127];
#pragma unroll
        for (int j = 0; j < 2; ++j) { const int idx = tid + 512 * j, tl = idx >> 3, c8 = (idx & 7) * 8; const float w = dts[tl] * __expf(a_end - acum[tl]);
            float u3[8], u2[8], u1[8], u0[8], f[8]; unpack8(xr[j][0], u3); unpack8(xr[j][1], u2); unpack8(xr[j][2], u1); unpack8(xr[j][3], u0);
            const LAS float* cwl = (const LAS float*)(lds + SD_CW) + c8;
#pragma unroll
            for (int i = 0; i < 8; i += 4) { const f32x4 q0 = *(const LAS f32x4*)(cwl + i), q1 = *(const LAS f32x4*)(cwl + 64 + i), q2 = *(const LAS f32x4*)(cwl + 128 + i), q3 = *(const LAS f32x4*)(cwl + 192 + i), qb = *(const LAS f32x4*)(cwl + 256 + i);
#pragma unroll
                for (int e = 0; e < 4; ++e) f[i + e] = siluf_(qb[e] + q0[e] * u3[i + e] + q1[e] * u2[i + e] + q2[e] * u1[i + e] + q3[e] * u0[i + e]); }
            *(LAS u32x4*)(lds + SD_XN + tl * SD_XP + c8 * 2) = pack8(f);
#pragma unroll
            for (int i = 0; i < 8; ++i) f[i] *= w;
            *(LAS u32x4*)(lds + SD_XW + tl * SD_XP + c8 * 2) = pack8(f); }
#pragma unroll
        for (int j = 0; j < 4; ++j) { const int idx = tid + 512 * j, tl = idx >> 4, n8 = (idx & 15) * 8; *(LAS u32x4*)(lds + SD_BN + tl * SD_P + n8 * 2) = br[j]; *(LAS u32x4*)(lds + SD_CN + tl * SD_P + n8 * 2) = cr[j]; }
        __syncthreads();
        if (c + 1 < SEQ / 128) SSD_LOAD_X(r0 + 128, false);
        {
            const int lrow = 32 * lb + r; const float acl = acum[lrow];
            const size_t row = r0 + lrow; u32x2 zw4[4];
#pragma unroll
            for (int g4 = 0; g4 < 4; ++g4) { const int p0 = 32 * pb + 8 * g4 + 4 * hh; zw4[g4] = *(const u32x2*)(zs + row * SSM_W + h * 64 + p0); }
            bf16x8 cf[8];
#pragma unroll
            for (int ks = 0; ks < 8; ++ks) cf[ks] = *(const LAS bf16x8*)(lds + SD_CN + lrow * SD_P + (16 * ks + 8 * hh) * 2);
            f32x16 acc;
#pragma unroll
            for (int i = 0; i < 16; ++i) acc[i] = zf;
#pragma unroll
            for (int ks = 0; ks < 8; ++ks) { const bf16x8 af = *(const LAS bf16x8*)(lds + SD_SI + (32 * pb + r) * SD_P + (16 * ks + 8 * hh) * 2); acc = MFMA32(af, cf[ks], acc); }
            { const float el = __expf(acl);
#pragma unroll
              for (int i = 0; i < 16; ++i) acc[i] *= el; }
#pragma unroll 1
            for (int sb = 0; sb <= lb; ++sb) {
                f32x16 cb;
#pragma unroll
                for (int i = 0; i < 16; ++i) cb[i] = zf;
#pragma unroll
                for (int ks = 0; ks < 8; ++ks) { const bf16x8 bfr = *(const LAS bf16x8*)(lds + SD_BN + (32 * sb + r) * SD_P + (16 * ks + 8 * hh) * 2); cb = MFMA32(bfr, cf[ks], cb); }
                u32x2 x0l, x0h, x1l, x1h;
                { const unsigned xa = trx + (unsigned)(SD_XN + (32 * sb + 4 * hh) * SD_XP); tr_read4(x0l, x0h, x1l, x1h, xa, xa + 8 * SD_XP, xa + 16 * SD_XP, xa + 24 * SD_XP); }
                float m[16];
#pragma unroll
                for (int g4 = 0; g4 < 4; ++g4) { const f32x4 as = *(const LAS f32x4*)(acum + 32 * sb + 8 * g4 + 4 * hh), ds = *(const LAS f32x4*)(dts + 32 * sb + 8 * g4 + 4 * hh);
#pragma unroll
                    for (int j = 0; j < 4; ++j) m[4 * g4 + j] = cb[4 * g4 + j] * __expf(acl - as[j]) * ds[j]; }
                if (sb == lb) {
#pragma unroll
                    for (int i = 0; i < 16; ++i) { const bool valid = ((i & 3) + 8 * (i >> 2) + 4 * hh) <= r; m[i] = valid ? m[i] : 0.f; }
                }
                u32x4 pw0, pw1;
                pw0.x = pk2(m[0], m[1]); pw0.y = pk2(m[2], m[3]); pw0.z = pk2(m[4], m[5]); pw0.w = pk2(m[6], m[7]);
                pw1.x = pk2(m[8], m[9]); pw1.y = pk2(m[10], m[11]); pw1.z = pk2(m[12], m[13]); pw1.w = pk2(m[14], m[15]);
                acc = MFMA32(__builtin_bit_cast(bf16x8, (u32x4){x0l.x, x0l.y, x0h.x, x0h.y}), __builtin_bit_cast(bf16x8, pw0), acc);
                acc = MFMA32(__builtin_bit_cast(bf16x8, (u32x4){x1l.x, x1l.y, x1h.x, x1h.y}), __builtin_bit_cast(bf16x8, pw1), acc);
            }
            if (c + 1 < SEQ / 128) SSD_LOAD_BC(r0 + 128);
            float ss = 0.f;
#pragma unroll
            for (int g4 = 0; g4 < 4; ++g4) { const int p0 = 32 * pb + 8 * g4 + 4 * hh;
                const u32x2 xw = *(const LAS u32x2*)(lds + SD_XN + lrow * SD_XP + p0 * 2), zw = zw4[g4];
                const float y0 = (acc[4 * g4] + Dh * bflo(xw.x)) * siluf_(bflo(zw.x)), y1 = (acc[4 * g4 + 1] + Dh * bfhi(xw.x)) * siluf_(bfhi(zw.x)), y2 = (acc[4 * g4 + 2] + Dh * bflo(xw.y)) * siluf_(bflo(zw.y)), y3 = (acc[4 * g4 + 3] + Dh * bfhi(xw.y)) * siluf_(bfhi(zw.y));
                ss += (y0 * y0 + y1 * y1) + (y2 * y2 + y3 * y3);
                u32x2 w; w.x = pk2(y0, y1); w.y = pk2(y2, y3); if (!DRY) *(u32x2*)(zs + row * SSM_W + h * 64 + p0) = w; }
            ssum[(pb * 2 + hh) * 128 + lrow] = ss;
        }
        __syncthreads();
        if (!DRY && tid < 128) ssq[(r0 + tid) * 32 + h] = (ssum[tid] + ssum[128 + tid]) + (ssum[256 + tid] + ssum[384 + tid]);
        { const float dec = __expf(a_end);
#pragma unroll
          for (int i = 0; i < 16; ++i) sacc[i] *= dec;
#pragma unroll
          for (int ks = 0; ks < 8; ++ks) { u32x2 bl_, bh_, xl_, xh_;
              const unsigned ba = trb + (unsigned)((16 * ks + 8 * hh) * SD_P), xa = trx + (unsigned)(SD_XW + (16 * ks + 8 * hh) * SD_XP);
              tr_read4(bl_, bh_, xl_, xh_, ba, ba + 4 * SD_P, xa, xa + 4 * SD_XP);
              sacc = MFMA32(__builtin_bit_cast(bf16x8, (u32x4){bl_.x, bl_.y, bh_.x, bh_.y}), __builtin_bit_cast(bf16x8, (u32x4){xl_.x, xl_.y, xh_.x, xh_.y}), sacc); }
#pragma unroll
          for (int g4 = 0; g4 < 4; ++g4) { u32x2 w; w.x = pk2(sacc[4 * g4], sacc[4 * g4 + 1]); w.y = pk2(sacc[4 * g4 + 2], sacc[4 * g4 + 3]);
              *(LAS u32x2*)(lds + SD_SI + (32 * pb + r) * SD_P + (32 * lb + 8 * g4 + 4 * hh) * 2) = w; } }
    }
#undef SSD_LOAD_X
#undef SSD_LOAD_BC
    __syncthreads();
}

constexpr int SB_KST = 144, SB_VST = 144;
constexpr int SB_KBUF = 64 * SB_KST, SB_VBUF = 64 * SB_VST;
__device__ __forceinline__ void sb_item(const Args& a, int bl, int hp, int qb, LAS unsigned char* lds, int wv) {
    const int tid = tid_opaque(wv), lane = tid & 63, wave = tid >> 6, r = lane & 31, hh = lane >> 5, grp = wave >> 2, h = hp * 2 + grp;
    const size_t rowbase = (size_t)bl * SEQ;
    const bf16_t* qkv = (const bf16_t*)(a.ws + WS_QKV); const bf16_t* sg = (const bf16_t*)(a.ws + WS_SG); bf16_t* sbo = (bf16_t*)(a.ws + WS_SBO);
    const int qw0 = qb * 128 + ((wave & 3) ^ (grp ? 3 : 0)) * 32, tq = qw0 + r;
    bf16x8 qf[4];
#pragma unroll
    for (int s = 0; s < 4; ++s) qf[s] = *(const bf16x8*)(qkv + (rowbase + tq) * 3072 + h * 64 + 16 * s + 8 * hh);
    float zf = 0.f; asm volatile("" : "+v"(zf));
    f32x16 o0, o1;
#pragma unroll
    for (int i = 0; i < 16; ++i) { o0[i] = zf; o1[i] = zf; }
    float carry = 1.f + zf;
    const int tg = tid & 255, kk = tg >> 3, c8 = (tg & 7) * 8;
    const int ntile = qb * 2 + 2;
    constexpr int SB_GRP = 2 * SB_KBUF + 2 * SB_VBUF;
    LAS unsigned char* gl = lds + grp * SB_GRP;
    const bf16_t* kg = qkv + rowbase * 3072 + 1024 + h * 64 + c8; const bf16_t* vg = qkv + rowbase * 3072 + 2048 + h * 64 + c8;
    u32x4 kreg[2], vreg[2];
#define SB_LOAD(t_) do { _Pragma("unroll") for (int j_ = 0; j_ < 2; ++j_) { kreg[j_] = *(const u32x4*)(kg + (size_t)((t_) * 64 + kk + 32 * j_) * 3072); vreg[j_] = *(const u32x4*)(vg + (size_t)((t_) * 64 + kk + 32 * j_) * 3072); } } while (0)
#define SB_STAGE(buf) do { LAS unsigned char* kb_ = gl + (buf) * SB_KBUF; LAS unsigned char* vb_ = gl + 2 * SB_KBUF + (buf) * SB_VBUF; \
        _Pragma("unroll") for (int j_ = 0; j_ < 2; ++j_) { *(LAS u32x4*)(kb_ + (kk + 32 * j_) * SB_KST + c8 * 2) = kreg[j_]; \
        *(LAS u32x4*)(vb_ + (kk + 32 * j_) * SB_VST + c8 * 2) = vreg[j_]; } } while (0)
    SB_LOAD(ntile - 1);
    LAS unsigned* flags = (LAS unsigned*)(lds + 2 * SB_GRP);
    __syncthreads();
    SB_STAGE(0);
    __syncthreads();
    int cur = 0; bool wdone = false;
    for (int tile = ntile - 1; tile >= 0; --tile) {
        const int k0 = tile * 64;
        if (tile > 0) SB_LOAD(tile - 1);
        if (k0 <= qw0 && !wdone) {
            const LAS unsigned char* kc = gl + cur * SB_KBUF; const LAS unsigned char* vc = gl + 2 * SB_KBUF + cur * SB_VBUF;
#pragma unroll 1
            for (int kb = 1; kb >= 0; --kb) {
                const int kbase = k0 + 32 * kb;
                if (kbase > qw0) continue;
                f32x16 sacc;
#pragma unroll
                for (int i = 0; i < 16; ++i) sacc[i] = zf;
#pragma unroll
                for (int s = 0; s < 4; ++s) { const bf16x8 kf = *(const LAS bf16x8*)(kc + (32 * kb + r) * SB_KST + (16 * s + 8 * hh) * 2); sacc = MFMA32(kf, qf[s], sacc); }
                u32x2 v00l, v00h, v01l, v01h, v10l, v10h, v11l, v11h;
                { const unsigned va = (unsigned)(size_t)vc + (unsigned)((32 * kb + 4 * hh + ((lane & 15) >> 2)) * SB_VST + (16 * ((lane >> 4) & 1) + 4 * (lane & 3)) * 2);
                  tr_read8(v00l, v00h, v01l, v01h, v10l, v10h, v11l, v11h, va, va + 8 * SB_VST, va + 64, va + 64 + 8 * SB_VST, va + 16 * SB_VST, va + 24 * SB_VST, va + 64 + 16 * SB_VST, va + 64 + 24 * SB_VST); }
                float bt[16], om[16];
#pragma unroll
                for (int i = 0; i < 16; ++i) { const float e = __builtin_amdgcn_exp2f(-__builtin_amdgcn_fmed3f(sacc[i], -126.f, 126.f)); bt[i] = __builtin_amdgcn_rcpf(1.f + e); om[i] = e * bt[i]; }
                if (kbase == qw0) {
#pragma unroll
                    for (int i = 0; i < 16; ++i) { const bool valid = ((i & 3) + 8 * (i >> 2) + 4 * hh) < r; om[i] = valid ? om[i] : 1.f; bt[i] = valid ? bt[i] : 0.f; }
                }
                float ex[16], T[4], PT[4];
#pragma unroll
                for (int g = 0; g < 4; ++g) { ex[4 * g + 3] = 1.f; ex[4 * g + 2] = om[4 * g + 3]; ex[4 * g + 1] = ex[4 * g + 2] * om[4 * g + 2]; ex[4 * g] = ex[4 * g + 1] * om[4 * g + 1]; T[g] = ex[4 * g] * om[4 * g]; }
#pragma unroll
                for (int g = 0; g < 4; ++g) PT[g] = shx(T[g], 32, lane);
                const float W0 = T[0] * PT[0], W1 = T[1] * PT[1], W2 = T[2] * PT[2], W3 = T[3] * PT[3];
                float base[4];
                base[3] = carry; base[2] = carry * W3; base[1] = base[2] * W2; base[0] = base[1] * W1;
                carry = base[0] * W0;
                if (hh == 0) {
#pragma unroll
                    for (int g = 0; g < 4; ++g) base[g] *= PT[g];
                }
                float p[16];
#pragma unroll
                for (int i = 0; i < 16; ++i) p[i] = bt[i] * (base[i >> 2] * ex[i]);
                u32x4 pw0, pw1;
                pw0.x = pk2(p[0], p[1]); pw0.y = pk2(p[2], p[3]); pw0.z = pk2(p[4], p[5]); pw0.w = pk2(p[6], p[7]);
                pw1.x = pk2(p[8], p[9]); pw1.y = pk2(p[10], p[11]); pw1.z = pk2(p[12], p[13]); pw1.w = pk2(p[14], p[15]);
                const bf16x8 pf0 = __builtin_bit_cast(bf16x8, pw0), pf1 = __builtin_bit_cast(bf16x8, pw1);
                o0 = MFMA32(__builtin_bit_cast(bf16x8, (u32x4){v00l.x, v00l.y, v00h.x, v00h.y}), pf0, o0); o1 = MFMA32(__builtin_bit_cast(bf16x8, (u32x4){v01l.x, v01l.y, v01h.x, v01h.y}), pf0, o1);
                o0 = MFMA32(__builtin_bit_cast(bf16x8, (u32x4){v10l.x, v10l.y, v10h.x, v10h.y}), pf1, o0); o1 = MFMA32(__builtin_bit_cast(bf16x8, (u32x4){v11l.x, v11l.y, v11h.x, v11h.y}), pf1, o1);
            }
        }
        wdone = (__builtin_amdgcn_ballot_w64(carry != 0.f) == 0ull);
        if (lane == 0) flags[(tile & 1) * 8 + wave] = wdone ? 1u : 0u;
        if (tile > 0) SB_STAGE(cur ^ 1);
        __syncthreads();
        cur ^= 1;
        { const LAS u32x4* fp = (const LAS u32x4*)(flags + (tile & 1) * 8); const u32x4 f0 = fp[0], f1 = fp[1];
          if ((f0.x & f0.y & f0.z & f0.w & f1.x & f1.y & f1.z & f1.w) != 0u) break; }
    }
#undef SB_STAGE
#undef SB_LOAD
    u32x2 gwv[2][4];
#pragma unroll
    for (int dblk = 0; dblk < 2; ++dblk)
#pragma unroll
        for (int g = 0; g < 4; ++g) gwv[dblk][g] = *(const u32x2*)(sg + (rowbase + tq) * 1024 + h * 64 + 32 * dblk + 8 * g + 4 * hh);
    __builtin_amdgcn_sched_barrier(0);
#pragma unroll
    for (int dblk = 0; dblk < 2; ++dblk)
#pragma unroll
        for (int g = 0; g < 4; ++g) { const size_t off = (rowbase + tq) * 1024 + h * 64 + 32 * dblk + 8 * g + 4 * hh; const u32x2 gw = gwv[dblk][g];
            const float v0 = (dblk ? o1[4 * g] : o0[4 * g]) * siluf_(bflo(gw.x)), v1 = (dblk ? o1[4 * g + 1] : o0[4 * g + 1]) * siluf_(bfhi(gw.x)), v2 = (dblk ? o1[4 * g + 2] : o0[4 * g + 2]) * siluf_(bflo(gw.y)), v3 = (dblk ? o1[4 * g + 3] : o0[4 * g + 3]) * siluf_(bfhi(gw.y));
            u32x2 w; w.x = pk2(v0, v1); w.y = pk2(v2, v3); *(u32x2*)(sbo + off) = w; }
    __syncthreads();
}

__device__ __forceinline__ void final_norm(const Args& a, int wv) {
    const int tid = tid_opaque(wv), lane = tid & 63, gw = blockIdx.x * 8 + (tid >> 6), NGW = gridDim.x * 8;
    const float* xss = (const float*)(a.ws + WS_XSS);
    f32x4 wn[4];
#pragma unroll
    for (int j = 0; j < 4; ++j) wn[j] = ((const f32x4*)a.final_norm_w + lane)[64 * j];
    for (int m0 = gw; m0 < M_ALL; m0 += 4 * NGW) {
        f32x4 v[4][4]; float sp[4];
#pragma unroll
        for (int q = 0; q < 4; ++q) { const int m = m0 + q * NGW; sp[q] = (lane < 16) ? xss[(size_t)m * 16 + lane] : 0.f;
#pragma unroll
            for (int j = 0; j < 4; ++j) v[q][j] = ((const f32x4*)(a.out + (size_t)m * DM) + lane)[64 * j]; }
#pragma unroll
        for (int q = 0; q < 4; ++q) { const int m = m0 + q * NGW; const float r = 1.f / sqrtf(wave_sum(sp[q], lane) * (1.f / DM) + EPS);
#pragma unroll
            for (int j = 0; j < 4; ++j) ((f32x4*)(a.out + (size_t)m * DM) + lane)[64 * j] = v[q][j] * r * wn[j]; }
    }
}

constexpr int N_PHASES = 1 + DEPTH * 2 * 5 + 1;

__global__ void __launch_bounds__(512, 2) mega(Args a0) {
    extern __shared__ __attribute__((aligned(16))) unsigned char lds_raw[];
    LAS unsigned char* lds = (LAS unsigned char*)lds_raw;
    const int G = gridDim.x, bx = blockIdx.x;
    const int wv = __builtin_amdgcn_readfirstlane((int)(threadIdx.x >> 6));
    volatile LAS unsigned* bst = (volatile LAS unsigned*)(lds + LDS_BYTES - 16);
    if (threadIdx.x < 4) bst[threadIdx.x] = 0u;
    __syncthreads();
    const XcdBarrier xbar = xcd_barrier_post((unsigned*)(a0.ws + WS_BAR), bst, threadIdx.x == 0);
    for (int ph = a0.ph_lo; ph < a0.ph_hi; ++ph) {
        Args a = a0;
        long zo = 0; asm volatile("" : "+s"(zo));
        a.x += zo; a.norm_w += zo; a.w_in += zo; a.conv_w += zo; a.conv_b += zo; a.dt_bias += zo; a.a_log += zo; a.d_skip += zo; a.ssm_norm_w += zo; a.pool_w += zo; a.pool_scale += zo;
        a.w_proj_ssm += zo; a.w_proj_pool += zo; a.w_proj_sb += zo; a.w_out += zo; a.final_norm_w += zo; a.out += zo; a.ws += zo;
        if (ph == 0) p0_prologue(a, lds, wv);
        else if (ph == N_PHASES - 1) final_norm(a, wv);
        else {
            const int q = ph - 1, l = q / 10, hf = (q % 10) / 5, k = q % 5;
            unsigned char* ws = a.ws;
            if (k == 1) {
                p2a_elementwise(a, l, wv);
            } else if (k == 2) {
                { pg8::Gemm g{(const bf16_t*)(ws + WS_MIXED), (const bf16_t*)(ws + WS_PW) + (size_t)l * 1024 * 256};
                  pg8::StaticOrder S; S.init(MH, 1024, G, bx);
                  EpiPool E{ws, a.pool_scale + l * 1024};
                  pg8::gemm_phase<EpiPool, 1024, 256, 256, 256>(lds, g, S, E, wv);
                }
                for (int it0 = bx; it0 < 8 * NHEAD; it0 += G) { int it = it0;
                    if (G == 256) { const int xcd = it0 & 7, slot = it0 >> 3, grp16 = xcd * 2 + (slot >> 4); it = (grp16 >> 1) * NHEAD + (grp16 & 1) * 16 + (slot & 15); }
                    ssd_item<false>(a, l, it / NHEAD, it % NHEAD, lds, wv); }
                for (int it0 = bx; it0 < 8 * 8 * 4; it0 += G) { int it = it0;
                    if (G == 256) { const int xcd = it0 & 7, slot = it0 >> 3; it = ((xcd * 8 + (slot >> 2)) << 2) | (slot & 3); }
                    const int bhp = it >> 2, sel = it & 3;
#pragma unroll 1
                    for (int j = 0; j < 4; ++j) { const int qbk = (j == 0) ? 15 - sel : (j == 1) ? sel : (j == 2) ? 8 + sel : 7 - sel; sb_item(a, bhp >> 3, bhp & 7, qbk, lds, wv); } }
            } else {
                const int nsub = (k == 3) ? 3 : 1;
#pragma unroll 1
                for (int sub = 0; sub < nsub; ++sub) {
                    if (k == 3 && sub == 0) {
                        pg8::StaticOrder S; S.init(MH, 1024, G, bx);
                        pg8::Gemm g{(const bf16_t*)(ws + WS_ZS), (const bf16_t*)(ws + WS_WSSM) + (size_t)l * 1024 * 2048};
                        p3_rstd((const float*)(ws + WS_SSQ), S, (LAS float*)(lds + RS_OFF), wv);
                        EpiMerge<0> E{ws, (const LAS float*)(lds + RS_OFF)};
                        pg8::gemm_phase<EpiMerge<0>, 2048, 2048, 2048, 0>(lds, g, S, E, wv);
                    } else {
                        const int mode = (k == 0) ? 0 : (k == 4) ? 3 : sub;
                        pg8::StaticOrder S; S.init(MH, mode == 0 ? NPAD : 1024, G, bx, mode == 0 ? P1_WGM : pg8::WGM);
                        const bf16_t* Ap = (mode == 0) ? (const bf16_t*)(ws + WS_XB) + (size_t)hf * MH * DM : (mode == 1) ? (const bf16_t*)(ws + WS_PU) : (mode == 2) ? (const bf16_t*)(ws + WS_SBO) : (const bf16_t*)(ws + WS_MB);
                        const bf16_t* Bp = (mode == 0) ? (const bf16_t*)(ws + WS_WIN) + (size_t)l * NPAD * 1024 : (const bf16_t*)(ws + (mode == 1 ? WS_WPOOL : mode == 2 ? WS_WSB : WS_WOUT)) + (size_t)l * 1024 * 1024;
                        pg8::Gemm g{Ap, Bp};
                        if (mode == 0) p1_rstd((const float*)(ws + WS_XSS) + (size_t)hf * MH * 16, S, (LAS float*)(lds + RS_OFF), wv);
                        EpiMulti E{mode, {(const LAS float*)(lds + RS_OFF), ws, a.dt_bias + l * NHEAD}, {ws, nullptr}, {ws, nullptr},
                                   {(l == 0 ? a.x : (const float*)a.out) + (size_t)hf * MH * DM, a.out + (size_t)hf * MH * DM, (bf16_t*)(ws + WS_XB) + (size_t)hf * MH * DM, (float*)(ws + WS_XSS) + (size_t)hf * MH * 16}};
                        pg8::gemm_phase<EpiMulti, 1024, 1024, 1024, 0>(lds, g, S, E, wv);
                    }
                }
            }
        }
        if (ph + 1 < a0.ph_hi) { if (a0.ph_lo < 0) cg::this_grid().sync(); else xcd_barrier(xbar, tid_opaque(wv) == 0); }
    }
}

extern "C" void kernel_launch(void* const* d_in, const int* in_sizes, int n_in, void* d_out, int out_size, void* d_ws, size_t ws_size, hipStream_t stream) {
    static int grid = 0;
    if (grid == 0) {
        if (ws_size < WS_END) { fprintf(stderr, "kernel_launch: workspace too small: %zu < %zu\n", ws_size, (size_t)WS_END); grid = -1; return; }
        int dev = 0, cus = 0, per_cu = 0;
        hipGetDevice(&dev); hipDeviceGetAttribute(&cus, hipDeviceAttributeMultiprocessorCount, dev);
        if (hipFuncSetAttribute((const void*)mega, hipFuncAttributeMaxDynamicSharedMemorySize, LDS_BYTES) != hipSuccess) { fprintf(stderr, "kernel_launch: hipFuncSetAttribute failed\n"); grid = -1; return; }
        if (hipOccupancyMaxActiveBlocksPerMultiprocessor(&per_cu, (const void*)mega, 512, LDS_BYTES) != hipSuccess || per_cu < 1) { fprintf(stderr, "kernel_launch: occupancy query says %d\n", per_cu); per_cu = 1; }
        (void)hipGetLastError();
        grid = cus * 1;
        if (grid <= 0) grid = 256;
    }
    if (grid < 0) return;
    (void)hipMemsetAsync((unsigned char*)d_ws + WS_BAR, 0, WS_BAR_BYTES, stream);
    Args a{};
    a.x = (const float*)d_in[0]; a.norm_w = (const float*)d_in[1]; a.w_in = (const float*)d_in[2]; a.conv_w = (const float*)d_in[3]; a.conv_b = (const float*)d_in[4];
    a.dt_bias = (const float*)d_in[5]; a.a_log = (const float*)d_in[6]; a.d_skip = (const float*)d_in[7]; a.ssm_norm_w = (const float*)d_in[8]; a.pool_w = (const float*)d_in[9];
    a.pool_scale = (const float*)d_in[10]; a.w_proj_ssm = (const float*)d_in[11]; a.w_proj_pool = (const float*)d_in[12]; a.w_proj_sb = (const float*)d_in[13]; a.w_out = (const float*)d_in[14];
    a.final_norm_w = (const float*)d_in[15]; a.out = (float*)d_out; a.ws = (unsigned char*)d_ws;
#if N_LAUNCH_MODE == 1
    a.ph_lo = 0; a.ph_hi = N_PHASES;
    void* args[] = {&a};
    hipError_t e = hipLaunchCooperativeKernel((const void*)mega, dim3(grid), dim3(512), args, LDS_BYTES, stream);
    if (e != hipSuccess) fprintf(stderr, "cooperative launch failed: %s (grid %d)\n", hipGetErrorString(e), grid);
#else
    for (int ph = 0; ph < N_PHASES; ++ph) { a.ph_lo = ph; a.ph_hi = ph + 1; hipLaunchKernelGGL(mega, dim3(grid), dim3(512), LDS_BYTES, stream, a); }
#endif
}
```
